# Optimizing an MI355X kernel written in HIP

```python
import math
import jax
import jax.numpy as jnp
from jax import lax
import numpy as np


D_MODEL = 1024
BATCH = 4
SEQ = 8192
DEPTH = 4

GRID_W = 64
CTX_LEN = 256

N_MIXERS = 2
D_FF = 4 * D_MODEL
N_MOD = 6
NORM_EPS = 1e-6

MLA_HEADS = 8
MLA_NOPE = 128
MLA_ROPE = 64
MLA_V = 128
MLA_Q_RANK = 384
MLA_KV_RANK = 256
ROPE_BASE = 10000.0
Q_BLOCK = 128

GLA_HEADS = 4
GLA_DK = D_MODEL // 2 // GLA_HEADS
GLA_DV = D_MODEL // GLA_HEADS
GLA_GATE_RANK = 16
GLA_TAU = 16.0
GLA_CHUNK = 64

kernel_name = 'hybrid_mla_gla_diffusion_trunk'


def rms_norm(x, g):
    xf = x.astype(jnp.float32)
    y = xf * lax.rsqrt(jnp.mean(xf * xf, axis=-1, keepdims=True) + NORM_EPS)
    return (y * g.astype(jnp.float32)).astype(x.dtype)


def modulate(h, shift, scale):
    return h * (1.0 + scale) + shift


def sqrelu_mlp(h, w1, w2):
    return jnp.square(jax.nn.relu(h @ w1)) @ w2


def axial_rope_tables(n_tokens):
    rows = n_tokens // GRID_W
    row = jnp.repeat(jnp.arange(rows, dtype=jnp.float32), GRID_W)
    col = jnp.tile(jnp.arange(GRID_W, dtype=jnp.float32), rows)
    half = MLA_ROPE // 2
    inv_freq = ROPE_BASE ** (-jnp.arange(0, half, 2, dtype=jnp.float32) / half)
    ang_r = row[:, None] * inv_freq
    ang_c = col[:, None] * inv_freq
    return (jnp.cos(ang_r), jnp.sin(ang_r), jnp.cos(ang_c), jnp.sin(ang_c))


def _rotate_half(x, cos, sin):
    x1, x2 = jnp.split(x, 2, axis=-1)
    return jnp.concatenate([x1 * cos - x2 * sin, x1 * sin + x2 * cos], axis=-1)


def apply_axial_rope(x, rope):
    cos_r, sin_r, cos_c, sin_c = rope
    if x.ndim == 4:
        cos_r, sin_r, cos_c, sin_c = (t[:, None, :] for t in rope)
    x_r, x_c = jnp.split(x, 2, axis=-1)
    out = jnp.concatenate([_rotate_half(x_r, cos_r, sin_r), _rotate_half(x_c, cos_c, sin_c)], axis=-1)
    return out.astype(x.dtype)


def mla_attend(q_nope, q_rope, k_nope, k_rope, v):
    scale = (MLA_NOPE + MLA_ROPE) ** -0.5
    s = (jnp.einsum('bqhd,bkhd->bhqk', q_nope, k_nope, preferred_element_type=jnp.float32)
         + jnp.einsum('bqhr,bkr->bhqk', q_rope, k_rope, preferred_element_type=jnp.float32))
    p = jax.nn.softmax(s * scale, axis=-1)
    return jnp.einsum('bhqk,bkhd->bqhd', p.astype(v.dtype), v)


def mla_mixer(h_ctx, h_lat, rope, need_ctx, w_dq, g_q, w_uq, w_dkv, g_kv, w_ukv, w_o):
    B, C, _ = h_ctx.shape
    S = h_lat.shape[1]
    T = C + S
    h_all = jnp.concatenate([h_ctx, h_lat], axis=1)
    cq = rms_norm(h_all @ w_dq, g_q)
    q = (cq @ w_uq).reshape(B, T, MLA_HEADS, MLA_NOPE + MLA_ROPE)
    ckv = h_all @ w_dkv
    c_kv = rms_norm(ckv[..., :MLA_KV_RANK], g_kv)
    kv = (c_kv @ w_ukv).reshape(B, T, MLA_HEADS, MLA_NOPE + MLA_V)
    q_nope, q_rope = q[..., :MLA_NOPE], q[..., MLA_NOPE:]
    k_nope, v = kv[..., :MLA_NOPE], kv[..., MLA_NOPE:]
    k_rope = ckv[..., MLA_KV_RANK:]
    q_rope = jnp.concatenate([q_rope[:, :C], apply_axial_rope(q_rope[:, C:], rope)], axis=1)
    k_rope = jnp.concatenate([k_rope[:, :C], apply_axial_rope(k_rope[:, C:], rope)], axis=1)

    nb = S // Q_BLOCK
    def to_blocks(a):
        return jnp.moveaxis(a.reshape(B, nb, Q_BLOCK, *a.shape[2:]), 1, 0)
    qn_blk = to_blocks(q_nope[:, C:])
    qr_blk = to_blocks(q_rope[:, C:])
    o_lat = lax.map(lambda qb: mla_attend(qb[0], qb[1], k_nope, k_rope, v), (qn_blk, qr_blk))
    o_lat = jnp.moveaxis(o_lat, 0, 1).reshape(B, S, MLA_HEADS * MLA_V)
    y_lat = o_lat @ w_o

    y_ctx = None
    if need_ctx:
        o_ctx = mla_attend(q_nope[:, :C], q_rope[:, :C], k_nope[:, :C], k_rope[:, :C], v[:, :C])
        y_ctx = o_ctx.reshape(B, C, MLA_HEADS * MLA_V) @ w_o
    return y_ctx, y_lat


def gla_log_gate(h, w1, w2, b):
    return jax.nn.log_sigmoid(((h @ w1) @ w2 + b).astype(jnp.float32)) / GLA_TAU


def gla_chunk_scan(q, k, v, g, s0):
    B, T, H, _ = q.shape
    n = T // GLA_CHUNK
    def to_chunks(a):
        return a.reshape(B, n, GLA_CHUNK, H, a.shape[-1]).transpose(1, 0, 3, 2, 4).astype(jnp.float32)
    mask = jnp.tril(jnp.ones((GLA_CHUNK, GLA_CHUNK), dtype=bool))
    def step(s, inp):
        qc, kc, vc, gc = inp
        G = jnp.cumsum(gc, axis=2)
        G_last = G[:, :, -1:, :]
        q_t = qc * jnp.exp(G)
        k_t = kc * jnp.exp(-G)
        a = jnp.where(mask, jnp.einsum('bhid,bhjd->bhij', q_t, k_t), 0.0)
        o = jnp.einsum('bhij,bhjv->bhiv', a, vc) + jnp.einsum('bhid,bhdv->bhiv', q_t, s)
        k_end = kc * jnp.exp(G_last - G)
        s_new = jnp.exp(G_last[:, :, 0, :])[..., None] * s + jnp.einsum('bhjd,bhjv->bhdv', k_end, vc)
        return s_new, o
    s_fin, o = lax.scan(step, s0, (to_chunks(q), to_chunks(k), to_chunks(v), to_chunks(g)))
    o = o.transpose(1, 0, 3, 2, 4).reshape(B, T, H, v.shape[-1])
    return o, s_fin


def gla_mixer(h_ctx, h_lat, need_ctx, w_q, w_k, w_v, w_r, w_gate1, w_gate2, b_gate, g_o, w_o):
    B, C, _ = h_ctx.shape
    S = h_lat.shape[1]
    T = C + S
    h_all = jnp.concatenate([h_ctx, h_lat], axis=1)
    def heads(a, d):
        return a.reshape(B, T, GLA_HEADS, d)
    q = heads(h_all @ w_q, GLA_DK) * (GLA_DK ** -0.5)
    k = heads(h_all @ w_k, GLA_DK)
    v = heads(h_all @ w_v, GLA_DV)
    g_fwd = heads(gla_log_gate(h_all, w_gate1[0], w_gate2[0], b_gate[0]), GLA_DK)
    g_bwd = heads(gla_log_gate(h_all, w_gate1[1], w_gate2[1], b_gate[1]), GLA_DK)
    flip = lambda a: jnp.flip(a, axis=1)
    zeros = jnp.zeros((B, GLA_HEADS, GLA_DK, GLA_DV), jnp.float32)
    qc, kc, vc = q[:, :C], k[:, :C], v[:, :C]
    ql, kl, vl = q[:, C:], k[:, C:], v[:, C:]
    o_cf, s_cf = gla_chunk_scan(qc, kc, vc, g_fwd[:, :C], zeros)
    o_cb, s_cb = gla_chunk_scan(flip(qc), flip(kc), flip(vc), flip(g_bwd[:, :C]), zeros)
    o_lf, _ = gla_chunk_scan(ql, kl, vl, g_fwd[:, C:], s_cf)
    o_lb, _ = gla_chunk_scan(flip(ql), flip(kl), flip(vl), flip(g_bwd[:, C:]), s_cb)
    def out(o, h):
        y = rms_norm(o, g_o).astype(h.dtype).reshape(B, -1, GLA_HEADS * GLA_DV)
        return (y * jax.nn.silu(h @ w_r)) @ w_o
    y_lat = out(o_lf + flip(o_lb), h_lat)
    y_ctx = out(o_cf + flip(o_cb), h_ctx) if need_ctx else None
    return y_ctx, y_lat


def setup_inputs(seed: int = 0) -> dict:
    key = jax.random.key(seed)
    ks = jax.random.split(key, 32)
    D = D_MODEL
    n_a = (DEPTH + N_MIXERS - 1) // N_MIXERS
    n_b = DEPTH // N_MIXERS
    def nrm(k, shape, scale):
        return jax.random.normal(k, shape, jnp.float32) * scale
    return {
        'x': nrm(ks[0], (BATCH, SEQ, D), 1.0),
        'c': nrm(ks[1], (BATCH, D), 1.0),
        'ctx': nrm(ks[2], (BATCH, CTX_LEN, D), 1.0),
        'c_ctx': nrm(ks[3], (D,), 1.0),
        'ada_w': nrm(ks[4], (DEPTH, D, N_MOD * D), 0.5 * D ** -0.5),
        'ada_b': nrm(ks[5], (DEPTH, N_MOD * D), 0.02),
        'norm_g': 1.0 + nrm(ks[6], (DEPTH, 4, D), 0.02),
        'mlp_w1': nrm(ks[7], (DEPTH, D, D_FF), D ** -0.5),
        'mlp_w2': nrm(ks[8], (DEPTH, D_FF, D), D_FF ** -0.5),
        'mla_w_dq': nrm(ks[9], (n_a, D, MLA_Q_RANK), D ** -0.5),
        'mla_g_q': 1.0 + nrm(ks[10], (n_a, MLA_Q_RANK), 0.02),
        'mla_w_uq': nrm(ks[11], (n_a, MLA_Q_RANK, MLA_HEADS * (MLA_NOPE + MLA_ROPE)), MLA_Q_RANK ** -0.5),
        'mla_w_dkv': nrm(ks[12], (n_a, D, MLA_KV_RANK + MLA_ROPE), D ** -0.5),
        'mla_g_kv': 1.0 + nrm(ks[13], (n_a, MLA_KV_RANK), 0.02),
        'mla_w_ukv': nrm(ks[14], (n_a, MLA_KV_RANK, MLA_HEADS * (MLA_NOPE + MLA_V)), MLA_KV_RANK ** -0.5),
        'mla_w_o': nrm(ks[15], (n_a, MLA_HEADS * MLA_V, D), (MLA_HEADS * MLA_V) ** -0.5),
        'gla_w_q': nrm(ks[16], (n_b, D, GLA_HEADS * GLA_DK), D ** -0.5),
        'gla_w_k': nrm(ks[17], (n_b, D, GLA_HEADS * GLA_DK), D ** -0.5),
        'gla_w_v': nrm(ks[18], (n_b, D, GLA_HEADS * GLA_DV), D ** -0.5),
        'gla_w_r': nrm(ks[19], (n_b, D, GLA_HEADS * GLA_DV), D ** -0.5),
        'gla_w_gate1': nrm(ks[20], (n_b, 2, D, GLA_GATE_RANK), D ** -0.5),
        'gla_w_gate2': nrm(ks[21], (n_b, 2, GLA_GATE_RANK, GLA_HEADS * GLA_DK), GLA_GATE_RANK ** -0.5),
        'gla_b_gate': nrm(ks[22], (n_b, 2, GLA_HEADS * GLA_DK), 0.1),
        'gla_g_o': 1.0 + nrm(ks[23], (n_b, GLA_DV), 0.02),
        'gla_w_o': nrm(ks[24], (n_b, GLA_HEADS * GLA_DV, D), (GLA_HEADS * GLA_DV) ** -0.5),
    }


def reference(x, c, ctx, c_ctx, ada_w, ada_b, norm_g, mlp_w1, mlp_w2,
              mla_w_dq, mla_g_q, mla_w_uq, mla_w_dkv, mla_g_kv, mla_w_ukv, mla_w_o,
              gla_w_q, gla_w_k, gla_w_v, gla_w_r, gla_w_gate1, gla_w_gate2, gla_b_gate,
              gla_g_o, gla_w_o):
    B, S, D = x.shape
    rope = axial_rope_tables(S)
    silu_c = jax.nn.silu(c)
    silu_cc = jax.nn.silu(c_ctx)
    x_lat, x_ctx = x, ctx
    for i in range(DEPTH):
        need_ctx = i < DEPTH - 1
        j = i // N_MIXERS
        m_lat = (silu_c @ ada_w[i] + ada_b[i]).reshape(B, N_MOD, 1, D)
        m_ctx = (silu_cc @ ada_w[i] + ada_b[i]).reshape(N_MOD, D)
        h_lat = modulate(rms_norm(x_lat, norm_g[i, 0]), m_lat[:, 0], m_lat[:, 1])
        h_ctx = modulate(rms_norm(x_ctx, norm_g[i, 0]), m_ctx[0], m_ctx[1])
        if i % N_MIXERS == 0:
            y_ctx, y_lat = mla_mixer(h_ctx, h_lat, rope, need_ctx, mla_w_dq[j], mla_g_q[j], mla_w_uq[j],
                                     mla_w_dkv[j], mla_g_kv[j], mla_w_ukv[j], mla_w_o[j])
        else:
            y_ctx, y_lat = gla_mixer(h_ctx, h_lat, need_ctx, gla_w_q[j], gla_w_k[j], gla_w_v[j], gla_w_r[j],
                                     gla_w_gate1[j], gla_w_gate2[j], gla_b_gate[j], gla_g_o[j], gla_w_o[j])
        x_lat = x_lat + m_lat[:, 2] * rms_norm(y_lat, norm_g[i, 1])
        h = modulate(rms_norm(x_lat, norm_g[i, 2]), m_lat[:, 3], m_lat[:, 4])
        x_lat = x_lat + m_lat[:, 5] * rms_norm(sqrelu_mlp(h, mlp_w1[i], mlp_w2[i]), norm_g[i, 3])
        if need_ctx:
            x_ctx = x_ctx + m_ctx[2] * rms_norm(y_ctx, norm_g[i, 1])
            h = modulate(rms_norm(x_ctx, norm_g[i, 2]), m_ctx[3], m_ctx[4])
            x_ctx = x_ctx + m_ctx[5] * rms_norm(sqrelu_mlp(h, mlp_w1[i], mlp_w2[i]), norm_g[i, 3])
    return x_lat
```

```cpp
#include <hip/hip_runtime.h>
#include <hip/hip_cooperative_groups.h>
#include <stdint.h>
#include <cstdio>
namespace cg = cooperative_groups;

typedef unsigned short u16;
using bf16x8 = __attribute__((ext_vector_type(8))) short;
using s16x4  = __attribute__((ext_vector_type(4))) short;
using f32x4  = __attribute__((ext_vector_type(4))) float;
using f32x16 = __attribute__((ext_vector_type(16))) float;
using u32x4  = __attribute__((ext_vector_type(4))) unsigned;
using u32x2  = __attribute__((ext_vector_type(2))) unsigned;
#define DEV __device__ __forceinline__

constexpr int DM = 1024, NBATCH = 4, SEQ = 8192, CTX = 256, TT = SEQ + CTX, MROWS = NBATCH * TT;
constexpr int NTHR = 512;
constexpr float EPS = 1e-6f;

struct Params {
  const float *x, *c, *ctx, *c_ctx, *ada_w, *ada_b, *norm_g, *mlp_w1, *mlp_w2,
      *mla_w_dq, *mla_g_q, *mla_w_uq, *mla_w_dkv, *mla_g_kv, *mla_w_ukv, *mla_w_o,
      *gla_w_q, *gla_w_k, *gla_w_v, *gla_w_r, *gla_w_gate1, *gla_w_gate2, *gla_b_gate, *gla_g_o, *gla_w_o;
  float* out;
  unsigned char* ws;
};

constexpr size_t SZ_MLA_W1 = 768 * 1024, SZ_MLA_UQ = 1536 * 384, SZ_MLA_UKV = 2048 * 256, SZ_WO = 1024 * 1024;
constexpr size_t SZ_MLA = SZ_MLA_W1 + SZ_MLA_UQ + SZ_MLA_UKV + SZ_WO;
constexpr size_t SZ_GLA_W1 = 3200 * 1024, SZ_GLA = SZ_GLA_W1 + SZ_WO;
constexpr size_t SZ_MLP1 = 4096 * 1024, SZ_MLP = 2 * SZ_MLP1;
constexpr size_t OFF_WMLA = 0, OFF_WGLA = 2 * SZ_MLA, OFF_WMLP = OFF_WGLA + 2 * SZ_GLA, W_TOTAL = OFF_WMLP + 4 * SZ_MLP;
constexpr size_t WS_W = 0;
constexpr size_t WS_MOD = WS_W + W_TOTAL * 2;
constexpr size_t WS_XCTX = WS_MOD + 4 * 5 * 6144 * 4;
constexpr size_t WS_STAT = WS_XCTX + (size_t)NBATCH * CTX * DM * 4;
constexpr size_t WS_H = WS_STAT + 4 * (size_t)MROWS * 4;
constexpr size_t WS_Y = WS_H + (size_t)MROWS * 1024 * 2;
constexpr size_t WS_R = WS_Y + (size_t)MROWS * 1024 * 2;
constexpr size_t WS_END = WS_R + (size_t)MROWS * 4096 * 2;
static_assert(WS_MOD % 256 == 0 && WS_H % 256 == 0 && WS_R % 256 == 0, "align");

constexpr int LDS_BYTES = 149520;

DEV u16 f2bf(float f) { unsigned u = __float_as_uint(f); u += 0x7fffu + ((u >> 16) & 1u); return (u16)(u >> 16); }
DEV float bf2f(u16 h) { return __uint_as_float(((unsigned)h) << 16); }
typedef __bf16 bf16x2_t __attribute__((ext_vector_type(2)));
DEV unsigned cvtpk(float lo, float hi) { bf16x2_t v = {(__bf16)lo, (__bf16)hi}; return __builtin_bit_cast(unsigned, v); }
DEV float bflo(unsigned u) { return __uint_as_float(u << 16); }
DEV float bfhi(unsigned u) { return __uint_as_float(u & 0xffff0000u); }
DEV int off128(int row, int ch) { return row * 128 + ((ch ^ ((row >> 1) & 7)) << 4); }
DEV int off256(int row, int ch) { return row * 256 + ((ch ^ (row & 15)) << 4); }
DEV f32x4 mfma16(bf16x8 a, bf16x8 b, f32x4 c) { return __builtin_amdgcn_mfma_f32_16x16x32_bf16(a, b, c, 0, 0, 0); }
DEV float wave_sum(float v) {
  v += __shfl_xor(v, 32); v += __shfl_xor(v, 16); v += __shfl_xor(v, 8); v += __shfl_xor(v, 4); v += __shfl_xor(v, 2); v += __shfl_xor(v, 1);
  return v;
}
#define VM_DRAIN() do { } while (0)
DEV int tidx() { int t = threadIdx.x; asm volatile("" : "+v"(t)); return t; }
DEV float silu_f(float v) { return v / (1.f + __expf(-v)); }
DEV void rope_sc(float pos, int f, float& sn, float& cs) {
  float invf = exp2f(-(float)f * 0.8304820237218406f);
  float rev = pos * invf * 0.15915494309189535f;
  rev = rev - floorf(rev);
  sn = __builtin_amdgcn_sinf(rev); cs = __builtin_amdgcn_cosf(rev);
}
#define rope_rot(A_, B_, POS_, F_) do { float sn_, cs_; rope_sc(POS_, F_, sn_, cs_); float a_ = (A_), b_ = (B_); (A_) = a_ * cs_ - b_ * sn_; (B_) = a_ * sn_ + b_ * cs_; } while (0)

DEV void tr_job(const float* __restrict__ src, int K, int N, u16* __restrict__ dst, const float* __restrict__ kscale, float scalar,
                int& rot, int vb, int G, float* tile) {
  const int tid = tidx();
  const int tn = N >> 6, tk = K >> 6, ntl = tn * tk;
  int start = (vb - (rot % G) + G) % G;
  for (int t = start; t < ntl; t += G) {
    int kb = t / tn, nb = t - kb * tn;
#pragma unroll
    for (int i = 0; i < 2; ++i) {
      int idx = tid + i * 512, r = idx >> 4, c4 = idx & 15;
      float4 v = *reinterpret_cast<const float4*>(src + (size_t)(kb * 64 + r) * N + nb * 64 + c4 * 4);
      float s = scalar * (kscale ? kscale[kb * 64 + r] : 1.f);
      float* tp = tile + r * 65 + c4 * 4;
      tp[0] = v.x * s; tp[1] = v.y * s; tp[2] = v.z * s; tp[3] = v.w * s;
    }
    __syncthreads();
    {
      int n = tid >> 3, k8 = (tid & 7) * 8;
      float e[8];
#pragma unroll
      for (int j = 0; j < 8; ++j) e[j] = tile[(k8 + j) * 65 + n];
      u32x4 w = {cvtpk(e[0], e[1]), cvtpk(e[2], e[3]), cvtpk(e[4], e[5]), cvtpk(e[6], e[7])};
      *reinterpret_cast<u32x4*>(dst + (size_t)(nb * 64 + n) * K + kb * 64 + k8) = w;
    }
    VM_DRAIN();
    __syncthreads();
  }
  rot += ntl;
}

DEV void phase0(const Params& p, int vb, int G, char* lds) {
  const int tid = tidx();
  u16* W = reinterpret_cast<u16*>(p.ws + WS_W);
  float* mod = reinterpret_cast<float*>(p.ws + WS_MOD);
  float* sc = reinterpret_cast<float*>(lds);
  float* red = sc + 5 * 1024;
  float* tile = red + 8 * 5 * 64;
  for (int idx = tid; idx < 5 * 1024; idx += NTHR) {
    int w = idx >> 10, k = idx & 1023;
    float v = (w < 4) ? p.c[w * 1024 + k] : p.c_ctx[k];
    sc[idx] = silu_f(v);
  }
  __syncthreads();
  for (int u = vb; u < 384; u += G) {
    int i = u / 96, n0 = (u - i * 96) * 64, cgi = tid & 63, kg = tid >> 6;
    float a0 = 0, a1 = 0, a2 = 0, a3 = 0, a4 = 0;
    const float* wp = p.ada_w + ((size_t)i * 1024 + kg * 128) * 6144 + n0 + cgi;
#pragma unroll 8
    for (int k = 0; k < 128; ++k) {
      float w = wp[(size_t)k * 6144];
      int kk = kg * 128 + k;
      a0 += sc[kk] * w; a1 += sc[1024 + kk] * w; a2 += sc[2048 + kk] * w; a3 += sc[3072 + kk] * w; a4 += sc[4096 + kk] * w;
    }
    red[(kg * 5 + 0) * 64 + cgi] = a0; red[(kg * 5 + 1) * 64 + cgi] = a1; red[(kg * 5 + 2) * 64 + cgi] = a2;
    red[(kg * 5 + 3) * 64 + cgi] = a3; red[(kg * 5 + 4) * 64 + cgi] = a4;
    __syncthreads();
    if (tid < 320) {
      int w5 = tid >> 6, cc = tid & 63;
      float s = p.ada_b[i * 6144 + n0 + cc];
#pragma unroll
      for (int g = 0; g < 8; ++g) s += red[(g * 5 + w5) * 64 + cc];
      mod[(size_t)(i * 5 + w5) * 6144 + n0 + cc] = s;
    }
    VM_DRAIN();
    __syncthreads();
  }
  int rot = 384;
  for (int j = 0; j < 2; ++j) {
    u16* wm = W + OFF_WMLA + j * SZ_MLA;
    tr_job(p.mla_w_dq + (size_t)j * 1024 * 384, 1024, 384, wm, nullptr, 1.f, rot, vb, G, tile);
    tr_job(p.mla_w_dkv + (size_t)j * 1024 * 320, 1024, 320, wm + 384 * 1024, nullptr, 1.f, rot, vb, G, tile);
    tr_job(p.mla_w_uq + (size_t)j * 384 * 1536, 384, 1536, wm + SZ_MLA_W1, p.mla_g_q + j * 384, 1.f, rot, vb, G, tile);
    tr_job(p.mla_w_ukv + (size_t)j * 256 * 2048, 256, 2048, wm + SZ_MLA_W1 + SZ_MLA_UQ, p.mla_g_kv + j * 256, 1.f, rot, vb, G, tile);
    tr_job(p.mla_w_o + (size_t)j * 1024 * 1024, 1024, 1024, wm + SZ_MLA_W1 + SZ_MLA_UQ + SZ_MLA_UKV, nullptr, 1.f, rot, vb, G, tile);
    u16* wg = W + OFF_WGLA + j * SZ_GLA;
    tr_job(p.gla_w_q + (size_t)j * 1024 * 512, 1024, 512, wg, nullptr, 0.08838834764831845f, rot, vb, G, tile);
    tr_job(p.gla_w_k + (size_t)j * 1024 * 512, 1024, 512, wg + 512 * 1024, nullptr, 1.f, rot, vb, G, tile);
    tr_job(p.gla_w_v + (size_t)j * 1024 * 1024, 1024, 1024, wg + 1024 * 1024, nullptr, 1.f, rot, vb, G, tile);
    tr_job(p.gla_w_r + (size_t)j * 1024 * 1024, 1024, 1024, wg + 2048 * 1024, nullptr, 1.f, rot, vb, G, tile);
    tr_job(p.gla_w_o + (size_t)j * 1024 * 1024, 1024, 1024, wg + SZ_GLA_W1, nullptr, 1.f, rot, vb, G, tile);
    for (int idx = vb * NTHR + tid; idx < 32768; idx += G * NTHR) {
      int dir = idx >> 14, r = (idx >> 10) & 15, k = idx & 1023;
      wg[(size_t)(3072 + dir * 16 + r) * 1024 + k] = f2bf(p.gla_w_gate1[(((size_t)j * 2 + dir) * 1024 + k) * 16 + r]);
    }
    for (int idx = vb * NTHR + tid; idx < 96 * 1024; idx += G * NTHR) wg[(size_t)3104 * 1024 + idx] = 0;
    for (int idx = vb * NTHR + tid; idx < 64 * 1024; idx += G * NTHR) wm[(size_t)704 * 1024 + idx] = 0;
    VM_DRAIN();
  }
  for (int i = 0; i < 4; ++i) {
    u16* wp = W + OFF_WMLP + i * SZ_MLP;
    tr_job(p.mlp_w1 + (size_t)i * 1024 * 4096, 1024, 4096, wp, nullptr, 1.f, rot, vb, G, tile);
    tr_job(p.mlp_w2 + (size_t)i * 4096 * 1024, 4096, 1024, wp + SZ_MLP1, nullptr, 1.f, rot, vb, G, tile);
  }
}

DEV void row_pass(const Params& p, int layer_add, int gate_idx, int gadd_idx,
                  int layer_norm, int sh_idx, int sc_idx, int gnorm_idx, bool first, bool last) {
  const int tid_ = tidx(); const int lane = tid_ & 63;
  const int gw = blockIdx.x * 8 + (tid_ >> 6), nw = gridDim.x * 8;
  const float* mod = reinterpret_cast<const float*>(p.ws + WS_MOD);
  float* xctx = reinterpret_cast<float*>(p.ws + WS_XCTX);
  u16* hbuf = reinterpret_cast<u16*>(p.ws + WS_H);
  const u16* ybuf = reinterpret_cast<const u16*>(p.ws + WS_Y);
  for (int m = gw; m < MROWS; m += nw) {
    int b = m / TT, t = m - b * TT;
    bool isctx = t < CTX;
    int w = isctx ? 4 : b;
    if (last && isctx) continue;
    float* xp = isctx ? xctx + (size_t)(b * CTX + t) * DM : p.out + ((size_t)b * SEQ + (t - CTX)) * DM;
    const float* xin = first ? (isctx ? p.ctx + (size_t)(b * CTX + t) * DM : p.x + ((size_t)b * SEQ + (t - CTX)) * DM) : xp;
    float4 xv[4];
#pragma unroll
    for (int q = 0; q < 4; ++q) xv[q] = *reinterpret_cast<const float4*>(xin + q * 256 + lane * 4);
    if (layer_add >= 0) {
      const float* gate = mod + (size_t)((layer_add * 5 + w) * 6 + gate_idx) * 1024;
      const float* g = p.norm_g + (size_t)(layer_add * 4 + gadd_idx) * 1024;
      u32x2 yy[4]; float ys = 0;
#pragma unroll
      for (int q = 0; q < 4; ++q) {
        yy[q] = *reinterpret_cast<const u32x2*>(ybuf + (size_t)m * 1024 + q * 256 + lane * 4);
        float y0 = bflo(yy[q][0]), y1 = bfhi(yy[q][0]), y2 = bflo(yy[q][1]), y3 = bfhi(yy[q][1]);
        ys += y0 * y0 + y1 * y1 + y2 * y2 + y3 * y3;
      }
      ys = wave_sum(ys);
      const float r = rsqrtf(ys * (1.f / 1024.f) + EPS);
#pragma unroll
      for (int q = 0; q < 4; ++q) {
        int col = q * 256 + lane * 4;
        float4 gt = *reinterpret_cast<const float4*>(gate + col);
        float4 gg = *reinterpret_cast<const float4*>(g + col);
        xv[q].x += gt.x * (gg.x * (bflo(yy[q][0]) * r)); xv[q].y += gt.y * (gg.y * (bfhi(yy[q][0]) * r));
        xv[q].z += gt.z * (gg.z * (bflo(yy[q][1]) * r)); xv[q].w += gt.w * (gg.w * (bfhi(yy[q][1]) * r));
      }
    }
    if (layer_add >= 0 || first) {
#pragma unroll
      for (int q = 0; q < 4; ++q) *reinterpret_cast<float4*>(xp + q * 256 + lane * 4) = xv[q];
    }
    if (layer_norm >= 0) {
      float ss = 0;
#pragma unroll
      for (int q = 0; q < 4; ++q) ss += xv[q].x * xv[q].x + xv[q].y * xv[q].y + xv[q].z * xv[q].z + xv[q].w * xv[q].w;
      ss = wave_sum(ss);
      float r0 = rsqrtf(ss * (1.f / 1024.f) + EPS);
      const float* sh = mod + (size_t)((layer_norm * 5 + w) * 6 + sh_idx) * 1024;
      const float* scl = mod + (size_t)((layer_norm * 5 + w) * 6 + sc_idx) * 1024;
      const float* g = p.norm_g + (size_t)(layer_norm * 4 + gnorm_idx) * 1024;
#pragma unroll
      for (int q = 0; q < 4; ++q) {
        int col = q * 256 + lane * 4;
        float4 s4 = *reinterpret_cast<const float4*>(sh + col);
        float4 c4 = *reinterpret_cast<const float4*>(scl + col);
        float4 gg = *reinterpret_cast<const float4*>(g + col);
        float h0 = (xv[q].x * r0 * gg.x) * (1.f + c4.x) + s4.x, h1 = (xv[q].y * r0 * gg.y) * (1.f + c4.y) + s4.y;
        float h2 = (xv[q].z * r0 * gg.z) * (1.f + c4.z) + s4.z, h3 = (xv[q].w * r0 * gg.w) * (1.f + c4.w) + s4.w;
        u32x2 pk = {cvtpk(h0, h1), cvtpk(h2, h3)};
        *reinterpret_cast<u32x2*>(hbuf + (size_t)m * 1024 + col) = pk;
      }
    }
    VM_DRAIN();
  }
}

DEV u32x4 widen16(u32x2 x, u32x2 y) {
  auto r0 = __builtin_amdgcn_permlane16_swap(x[0], y[0], false, false);
  auto r1 = __builtin_amdgcn_permlane16_swap(x[1], y[1], false, false);
  return u32x4{r0[0], r1[0], r0[1], r1[1]};
}
struct Epi { u16* o0; u16* o1; u16* o2; float* f0; float* s0; float* s1; const float* r0; };
enum { E_Y = 0, E_MLP1 = 1, E_MLA1 = 2, E_MLAQ = 3, E_MLAKV = 4, E_GLA1 = 5 };

template <int EPI, int MT = 4>
DEV void gemm_phase(const u16* __restrict__ A, int lda, const u16* __restrict__ Bt, int K, int N, int rot, int vb, int G, char* lds, const Epi& e) {
  int tid = threadIdx.x; asm volatile("" : "+v"(tid)); const int lane = tid & 63, w = tid >> 6, wm = w >> 1, wn = w & 1, l15 = lane & 15, lq = lane >> 4;
  const int ntn = N >> 7, total = (MROWS / (64 * MT)) * ntn, nk = K >> 6;
  char* As = lds; char* Bs = lds + 98304;
  const int srow = tid >> 3, sch = tid & 7;
  if (__builtin_amdgcn_readfirstlane(w) >= 4) __builtin_amdgcn_s_setprio(1);
  int start = (vb - (rot % G) + G) % G;
  for (int t = start; t < total; t += G) {
    int mb = t / ntn, nb = t - mb * ntn;
    if (MT == 4 && ntn > 8 && (ntn & 7) == 0) {
      const int sidx = t >> 5, j5 = t & 31, scols = ntn >> 3, smb = sidx / scols, snb = sidx - smb * scols;
      mb = smb * 4 + (j5 >> 3); nb = snb * 8 + (j5 & 7);
    }
    const int m0 = mb * (64 * MT), n0 = nb * 128;
    f32x4 acc[4][MT];
    float zf_ = 0.f; asm volatile("" : "+v"(zf_));
#pragma unroll
    for (int i = 0; i < 4; ++i)
#pragma unroll
      for (int j = 0; j < MT; ++j) acc[i][j] = f32x4{zf_, zf_, zf_, zf_};
    auto stage = [&](int kt, int buf) {
#pragma unroll
      for (int i = 0; i < MT; ++i) { const int row = srow + i * 64;
        const u16* g = A + (size_t)(m0 + row) * lda + kt * 64 + ((sch ^ ((row >> 1) & 7)) << 3);
        __builtin_amdgcn_global_load_lds((const unsigned*)g, (unsigned*)(As + buf * 32768 + row * 128 + sch * 16), 16, 0, 0); }
#pragma unroll
      for (int i = 0; i < 2; ++i) { const int row = srow + i * 64;
        const u16* g = Bt + (size_t)(n0 + row) * K + kt * 64 + ((sch ^ ((row >> 1) & 7)) << 3);
        __builtin_amdgcn_global_load_lds((const unsigned*)g, (unsigned*)(Bs + buf * 16384 + row * 128 + sch * 16), 16, 0, 0); }
    };
    if constexpr (EPI == E_MLAQ || EPI == E_MLAKV) {
      __syncthreads();
      const int rrow = tid >> 1, hh = tid & 1, kh = K >> 1;
      const u16* ap = A + (size_t)(m0 + rrow) * lda + hh * kh;
      float ss = 0;
      for (int c = 0; c < kh; c += 8) {
        u32x4 v = *reinterpret_cast<const u32x4*>(ap + c);
#pragma unroll
        for (int z = 0; z < 4; ++z) { float lo = bflo(v[z]), hi2 = bfhi(v[z]); ss += lo * lo + hi2 * hi2; }
      }
      ss += __shfl_xor(ss, 1);
      if (hh == 0) reinterpret_cast<float*>(lds + 147456)[rrow] = rsqrtf(ss / (float)K + EPS);
    }
    if constexpr (EPI == E_MLAQ || EPI == E_MLAKV) {
      asm volatile("s_waitcnt vmcnt(0) lgkmcnt(0)" ::: "memory");
      __syncthreads();
    }
    stage(0, 0); stage(1, 1);
    int cb = 0, pb = 2;
    for (int kt = 0; kt < nk; ++kt) {
      if (kt + 1 < nk) asm volatile("s_waitcnt vmcnt(%0)" :: "n"(MT + 2) : "memory"); else asm volatile("s_waitcnt vmcnt(0)" ::: "memory");
      __builtin_amdgcn_s_barrier();
      __builtin_amdgcn_sched_barrier(0);
      const char* Ac = As + cb * 32768; const char* Bc = Bs + cb * 16384;
      bf16x8 bw[2][4], at[2][MT];
#pragma unroll
      for (int kk = 0; kk < 2; ++kk) {
        const int ch = kk * 4 + lq;
#pragma unroll
        for (int nt = 0; nt < 4; ++nt) bw[kk][nt] = *reinterpret_cast<const bf16x8*>(Bc + off128(wn * 64 + nt * 16 + l15, ch));
#pragma unroll
        for (int mt = 0; mt < MT; ++mt) at[kk][mt] = *reinterpret_cast<const bf16x8*>(Ac + off128(wm * (16 * MT) + mt * 16 + l15, ch));
      }
      __builtin_amdgcn_sched_barrier(0);
      if (kt + 2 < nk) stage(kt + 2, pb);
      __builtin_amdgcn_sched_barrier(0);
#pragma unroll
      for (int kk = 0; kk < 2; ++kk)
#pragma unroll
        for (int nt = 0; nt < 4; ++nt)
#pragma unroll
          for (int mt = 0; mt < MT; ++mt) acc[nt][mt] = mfma16(bw[kk][nt], at[kk][mt], acc[nt][mt]);
      cb = (cb == 2) ? 0 : cb + 1; pb = (pb == 2) ? 0 : pb + 1;
    }
    asm volatile("s_waitcnt lgkmcnt(0)" ::: "memory");
    __syncthreads();
    const int nw = n0 + wn * 64;
    const int mbase = m0 + wm * (16 * MT) + l15;
    const int nl = lq * 4;
    if constexpr (EPI == E_Y) {
#pragma unroll
      for (int mt = 0; mt < MT; ++mt) {
        const int m = mbase + mt * 16;
#pragma unroll
        for (int nt = 0; nt < 4; nt += 2) {
          f32x4 v = acc[nt][mt], v2 = acc[nt + 1][mt];
          u32x4 wv = widen16(u32x2{cvtpk(v[0], v[1]), cvtpk(v[2], v[3])}, u32x2{cvtpk(v2[0], v2[1]), cvtpk(v2[2], v2[3])});
          *reinterpret_cast<u32x4*>(e.o0 + (size_t)m * 1024 + nw + (nt + (lq & 1)) * 16 + (lq & 2) * 4) = wv;
        }
      }
    } else if constexpr (EPI == E_MLP1) {
#pragma unroll
      for (int mt = 0; mt < MT; ++mt) {
        const int m = mbase + mt * 16;
#pragma unroll
        for (int nt = 0; nt < 4; nt += 2) {
          f32x4 v = acc[nt][mt], v2 = acc[nt + 1][mt];
#pragma unroll
          for (int j = 0; j < 4; ++j) { float r = fmaxf(v[j], 0.f); v[j] = r * r; float r2 = fmaxf(v2[j], 0.f); v2[j] = r2 * r2; }
          u32x4 wv = widen16(u32x2{cvtpk(v[0], v[1]), cvtpk(v[2], v[3])}, u32x2{cvtpk(v2[0], v2[1]), cvtpk(v2[2], v2[3])});
          *reinterpret_cast<u32x4*>(e.o0 + (size_t)m * 4096 + nw + (nt + (lq & 1)) * 16 + (lq & 2) * 4) = wv;
        }
      }
    } else if constexpr (EPI == E_MLA1) {
      if (nw < 640) {
        const bool isq = nw < 384;
#pragma unroll
        for (int mt = 0; mt < MT; ++mt) {
          const int m = mbase + mt * 16;
#pragma unroll
          for (int nt = 0; nt < 4; nt += 2) {
            f32x4 v = acc[nt][mt], v2 = acc[nt + 1][mt];
            u32x4 wv = widen16(u32x2{cvtpk(v[0], v[1]), cvtpk(v[2], v[3])}, u32x2{cvtpk(v2[0], v2[1]), cvtpk(v2[2], v2[3])});
            if (isq) *reinterpret_cast<u32x4*>(e.o0 + (size_t)m * 384 + nw + (nt + (lq & 1)) * 16 + (lq & 2) * 4) = wv;
            else     *reinterpret_cast<u32x4*>(e.o1 + (size_t)m * 256 + (nw - 384) + (nt + (lq & 1)) * 16 + (lq & 2) * 4) = wv;
          }
        }
      } else if (nw == 640) {
#pragma unroll
        for (int mt = 0; mt < MT; ++mt) {
          const int m = mbase + mt * 16; const int tt = m % TT;
          if (tt >= CTX) {
            const int pos = tt - CTX; const float pr = (float)(pos >> 6), pc = (float)(pos & 63);
#pragma unroll
            for (int j = 0; j < 4; ++j) {
              rope_rot(acc[0][mt][j], acc[1][mt][j], pr, nl + j);
              rope_rot(acc[2][mt][j], acc[3][mt][j], pc, nl + j);
            }
          }
#pragma unroll
          for (int nt = 0; nt < 4; nt += 2) {
            f32x4 v = acc[nt][mt], v2 = acc[nt + 1][mt];
            u32x4 wv = widen16(u32x2{cvtpk(v[0], v[1]), cvtpk(v[2], v[3])}, u32x2{cvtpk(v2[0], v2[1]), cvtpk(v2[2], v2[3])});
            *reinterpret_cast<u32x4*>(e.o2 + (size_t)m * 64 + (nt + (lq & 1)) * 16 + (lq & 2) * 4) = wv;
          }
        }
      }
    } else if constexpr (EPI == E_MLAQ) {
      const bool ropet = (nw % 192) == 128;
#pragma unroll
      for (int mt = 0; mt < MT; ++mt) {
        const int m = mbase + mt * 16; const int tt = m % TT;
        const float rs = reinterpret_cast<const float*>(lds + 147456)[wm * 64 + mt * 16 + l15];
#pragma unroll
        for (int nt = 0; nt < 4; ++nt) acc[nt][mt] = acc[nt][mt] * rs;
        if (ropet && tt >= CTX) {
          const int pos = tt - CTX; const float pr = (float)(pos >> 6), pc = (float)(pos & 63);
#pragma unroll
          for (int j = 0; j < 4; ++j) {
            rope_rot(acc[0][mt][j], acc[1][mt][j], pr, nl + j);
            rope_rot(acc[2][mt][j], acc[3][mt][j], pc, nl + j);
          }
        }
#pragma unroll
        for (int nt = 0; nt < 4; nt += 2) {
          f32x4 v = acc[nt][mt], v2 = acc[nt + 1][mt];
          u32x4 wv = widen16(u32x2{cvtpk(v[0], v[1]), cvtpk(v[2], v[3])}, u32x2{cvtpk(v2[0], v2[1]), cvtpk(v2[2], v2[3])});
          *reinterpret_cast<u32x4*>(e.o0 + (size_t)m * 1536 + nw + (nt + (lq & 1)) * 16 + (lq & 2) * 4) = wv;
        }
      }
    } else if constexpr (EPI == E_MLAKV) {
#pragma unroll
      for (int mt = 0; mt < MT; ++mt) {
        const int m = mbase + mt * 16;
        const float rs = reinterpret_cast<const float*>(lds + 147456)[wm * 64 + mt * 16 + l15];
#pragma unroll
        for (int nt = 0; nt < 4; nt += 2) {
          f32x4 v = acc[nt][mt] * rs, v2 = acc[nt + 1][mt] * rs;
          u32x4 wv = widen16(u32x2{cvtpk(v[0], v[1]), cvtpk(v[2], v[3])}, u32x2{cvtpk(v2[0], v2[1]), cvtpk(v2[2], v2[3])});
          *reinterpret_cast<u32x4*>(e.o0 + (size_t)m * 2048 + nw + (nt + (lq & 1)) * 16 + (lq & 2) * 4) = wv;
        }
      }
    } else if constexpr (EPI == E_GLA1) {
      if (nw < 3072) {
        u16* dst = e.o0 + (size_t)(nw >> 10) * ((size_t)MROWS * 1024);
        const int nc = nw & 1023; const bool dosilu = nw >= 2048;
#pragma unroll
        for (int mt = 0; mt < MT; ++mt) {
          const int m = mbase + mt * 16;
#pragma unroll
          for (int nt = 0; nt < 4; nt += 2) {
            f32x4 v = acc[nt][mt], v2 = acc[nt + 1][mt];
            if (dosilu) {
#pragma unroll
              for (int j = 0; j < 4; ++j) { v[j] = silu_f(v[j]); v2[j] = silu_f(v2[j]); }
            }
            u32x4 wv = widen16(u32x2{cvtpk(v[0], v[1]), cvtpk(v[2], v[3])}, u32x2{cvtpk(v2[0], v2[1]), cvtpk(v2[2], v2[3])});
            *reinterpret_cast<u32x4*>(dst + (size_t)m * 1024 + nc + (nt + (lq & 1)) * 16 + (lq & 2) * 4) = wv;
          }
        }
      } else if (nw == 3072) {
#pragma unroll
        for (int mt = 0; mt < MT; ++mt) {
          const int m = mbase + mt * 16;
#pragma unroll
          for (int nt = 0; nt < 2; ++nt) *reinterpret_cast<f32x4*>(e.f0 + (size_t)m * 32 + nt * 16 + nl) = acc[nt][mt];
        }
      }
    }
    VM_DRAIN();
  }
  __builtin_amdgcn_s_setprio(0);
}

constexpr int KVBLK = 64;
constexpr float ATT_SCALE = 0.07216878364870322f;
constexpr float ATT_THR = 8.f;
constexpr int SHM_K = KVBLK * 192 * 2, SHM_V = KVBLK * 128 * 2;
#define KSWZ(row, colB) ((row) * 384 + ((colB) ^ ((((row) >> 1) & 7) << 4)))
#define SBAR() __builtin_amdgcn_sched_barrier(0)
DEV int crow(int r, int hi) { return (r & 3) + 8 * (r >> 2) + 4 * hi; }

DEV void partialSM(f32x16& p0, f32x16& p1, float& m_reg, float& mn, float& alpha) {
  constexpr float C = ATT_SCALE * 1.4426950408889634f;
  float pmax = p0[0];
#pragma unroll
  for (int r = 1; r < 16; ++r) pmax = fmaxf(pmax, p0[r]);
#pragma unroll
  for (int r = 0; r < 16; ++r) pmax = fmaxf(pmax, p1[r]);
  { auto rr = __builtin_amdgcn_permlane32_swap(__float_as_uint(pmax), __float_as_uint(pmax), false, false);
    pmax = fmaxf(__uint_as_float(rr[0]), __uint_as_float(rr[1])); }
  if (__builtin_expect(__all(pmax - m_reg <= ATT_THR / ATT_SCALE), 1)) { mn = m_reg; alpha = 1.f; }
  else { mn = fmaxf(m_reg, pmax); alpha = __builtin_amdgcn_exp2f((m_reg - mn) * C); m_reg = mn; }
  float mnC = -mn * C;
#pragma unroll
  for (int r = 0; r < 16; ++r) p0[r] = fmaf(p0[r], C, mnC);
#pragma unroll
  for (int r = 0; r < 16; ++r) p1[r] = fmaf(p1[r], C, mnC);
#pragma unroll
  for (int r = 0; r < 16; ++r) p0[r] = __builtin_amdgcn_exp2f(p0[r]);
}
DEV void finishSM(f32x16& p0, f32x16& p1, float alpha, float& l_reg, bf16x8& pa0, bf16x8& pa1, bf16x8& pa2, bf16x8& pa3) {
#pragma unroll
  for (int r = 0; r < 16; ++r) p1[r] = __builtin_amdgcn_exp2f(p1[r]);
  float ps = 0;
#pragma unroll
  for (int r = 0; r < 16; ++r) ps += p0[r];
#pragma unroll
  for (int r = 0; r < 16; ++r) ps += p1[r];
  { auto rr = __builtin_amdgcn_permlane32_swap(__float_as_uint(ps), __float_as_uint(ps), false, false);
    ps = __uint_as_float(rr[0]) + __uint_as_float(rr[1]); }
  l_reg = l_reg * alpha + ps;
#define PK4(P, BASE, OUT) do { unsigned a0 = cvtpk(P[BASE + 0], P[BASE + 1]), a1 = cvtpk(P[BASE + 2], P[BASE + 3]);   \
    unsigned b0 = cvtpk(P[BASE + 4], P[BASE + 5]), b1 = cvtpk(P[BASE + 6], P[BASE + 7]);                              \
    auto r0 = __builtin_amdgcn_permlane32_swap(a0, b0, false, false); auto r1 = __builtin_amdgcn_permlane32_swap(a1, b1, false, false); \
    u32x4 w = {r0[0], r1[0], r0[1], r1[1]}; OUT = *reinterpret_cast<bf16x8*>(&w); } while (0)
  PK4(p0, 0, pa0); PK4(p0, 8, pa1); PK4(p1, 0, pa2); PK4(p1, 8, pa3);
#undef PK4
}
DEV void qkt(f32x16& p0, f32x16& p1, const char* Ks, const bf16x8* qr, int r32, int hi) {
  { float zf = 0.f; asm volatile("" : "+v"(zf));
#pragma unroll
    for (int r = 0; r < 16; ++r) { p0[r] = zf; p1[r] = zf; } }
#pragma unroll
  for (int d0 = 0; d0 < 12; ++d0) { int cb = (d0 * 16 + hi * 8) * 2;
    bf16x8 b0 = *reinterpret_cast<const bf16x8*>(Ks + KSWZ(r32, cb));
    bf16x8 b1 = *reinterpret_cast<const bf16x8*>(Ks + KSWZ(32 + r32, cb));
    p0 = __builtin_amdgcn_mfma_f32_32x32x16_bf16(b0, qr[d0], p0, 0, 0, 0);
    p1 = __builtin_amdgcn_mfma_f32_32x32x16_bf16(b1, qr[d0], p1, 0, 0, 0); }
}
DEV int v_st(int k, int c) { const int kk = (k & ~0xC) | ((k & 4) << 1) | ((k & 8) >> 1); return ((kk >> 3) * 4 + (c >> 5)) * 512 + ((kk & 7) * 32 + (c & 31)) * 2; }
DEV int v_rd_base(int lane) { return ((lane & 3) << 3) | (((lane >> 2) & 3) << 6) | (((lane >> 4) & 1) << 5) | (((lane >> 5) & 1) << 8); }
constexpr int v_rd_off(int d0, int ks, int half) { return d0 * 512 + ks * 4096 + half * 2048; }
template <int OFF> DEV s16x4 tr_read(int vb) {
  s16x4 r; asm volatile("ds_read_b64_tr_b16 %0, %1 offset:%2" : "=&v"(r) : "v"(vb), "i"(OFF) : "memory"); return r;
}
template <int D0> DEV void pv_one(f32x16& od, int vb, bf16x8 pa0, bf16x8 pa1, bf16x8 pa2, bf16x8 pa3) {
  s16x4 l0, h0, l1, h1, l2, h2, l3, h3;
  asm volatile("ds_read_b64_tr_b16 %0, %8 offset:%9\n\t"
               "ds_read_b64_tr_b16 %1, %8 offset:%10\n\t"
               "ds_read_b64_tr_b16 %2, %8 offset:%11\n\t"
               "ds_read_b64_tr_b16 %3, %8 offset:%12\n\t"
               "ds_read_b64_tr_b16 %4, %8 offset:%13\n\t"
               "ds_read_b64_tr_b16 %5, %8 offset:%14\n\t"
               "ds_read_b64_tr_b16 %6, %8 offset:%15\n\t"
               "ds_read_b64_tr_b16 %7, %8 offset:%16\n\t"
               "s_waitcnt lgkmcnt(0)"
               : "=&v"(l0), "=&v"(h0), "=&v"(l1), "=&v"(h1), "=&v"(l2), "=&v"(h2), "=&v"(l3), "=&v"(h3)
               : "v"(vb), "i"(v_rd_off(D0, 0, 0)), "i"(v_rd_off(D0, 0, 1)), "i"(v_rd_off(D0, 1, 0)), "i"(v_rd_off(D0, 1, 1)),
                 "i"(v_rd_off(D0, 2, 0)), "i"(v_rd_off(D0, 2, 1)), "i"(v_rd_off(D0, 3, 0)), "i"(v_rd_off(D0, 3, 1))
               : "memory");
  SBAR();
#define PKV(L, H) (bf16x8){L[0], L[1], L[2], L[3], H[0], H[1], H[2], H[3]}
  od = __builtin_amdgcn_mfma_f32_32x32x16_bf16(pa0, PKV(l0, h0), od, 0, 0, 0);
  od = __builtin_amdgcn_mfma_f32_32x32x16_bf16(pa1, PKV(l1, h1), od, 0, 0, 0);
  od = __builtin_amdgcn_mfma_f32_32x32x16_bf16(pa2, PKV(l2, h2), od, 0, 0, 0);
  od = __builtin_amdgcn_mfma_f32_32x32x16_bf16(pa3, PKV(l3, h3), od, 0, 0, 0);
#undef PKV
}
DEV void pv_d0(f32x16* o, int vb, bf16x8 pa0, bf16x8 pa1, bf16x8 pa2, bf16x8 pa3) {
  pv_one<0>(o[0], vb, pa0, pa1, pa2, pa3); pv_one<1>(o[1], vb, pa0, pa1, pa2, pa3); pv_one<2>(o[2], vb, pa0, pa1, pa2, pa3); pv_one<3>(o[3], vb, pa0, pa1, pa2, pa3);
}

DEV void attn_body(const u16* __restrict__ Qb, const u16* __restrict__ Kn, const u16* __restrict__ Kr, const u16* __restrict__ Vh,
                   u16* __restrict__ Ob, int seq, char* lds) {
  int tid = threadIdx.x; asm volatile("" : "+v"(tid)); const int wid = tid >> 6, lane = tid & 63, r32 = lane & 31, hi = lane >> 5;
  char* V_lds = lds; char* K_lds = lds + 2 * SHM_V;
  float* wsl = reinterpret_cast<float*>(lds + 2 * SHM_V + 2 * SHM_K) + wid * 64; float* li_l = wsl; float* al_l = wsl + 32;
  asm volatile("s_waitcnt vmcnt(0) lgkmcnt(0)" ::: "memory");
  __syncthreads();
  float m_reg = -1e30f, l_reg = 0; f32x16 o[4] = {}; bf16x8 qr[12];
  const u16* Qw = Qb + (size_t)(wid * 32 + r32) * 1536 + hi * 8;
#pragma unroll
  for (int d0 = 0; d0 < 12; ++d0) qr[d0] = *reinterpret_cast<const bf16x8*>(Qw + d0 * 16);
  const int sr = tid >> 4, sc = (tid & 15) * 8, vst0 = v_st(sr, sc), vst1 = v_st(32 + sr, sc);
  const int rr_ = tid >> 3, rc_ = (tid & 7) * 8;
  const int vb0 = (int)(uintptr_t)V_lds + v_rd_base(lane);
  bf16x8 vs0, vs1, ks0, ks1, kr0;
#define SLOAD(k0) do { vs0 = *reinterpret_cast<const bf16x8*>(Vh + (size_t)((k0) + sr) * 2048 + sc); vs1 = *reinterpret_cast<const bf16x8*>(Vh + (size_t)((k0) + 32 + sr) * 2048 + sc); \
    ks0 = *reinterpret_cast<const bf16x8*>(Kn + (size_t)((k0) + sr) * 2048 + sc); ks1 = *reinterpret_cast<const bf16x8*>(Kn + (size_t)((k0) + 32 + sr) * 2048 + sc); \
    kr0 = *reinterpret_cast<const bf16x8*>(Kr + (size_t)((k0) + rr_) * 64 + rc_); } while (0)
#define SWRITE(b) do { *reinterpret_cast<bf16x8*>(V_lds + (b) * SHM_V + vst0) = vs0; *reinterpret_cast<bf16x8*>(V_lds + (b) * SHM_V + vst1) = vs1; \
    *reinterpret_cast<bf16x8*>(K_lds + (b) * SHM_K + KSWZ(sr, sc * 2)) = ks0; *reinterpret_cast<bf16x8*>(K_lds + (b) * SHM_K + KSWZ(32 + sr, sc * 2)) = ks1; \
    *reinterpret_cast<bf16x8*>(K_lds + (b) * SHM_K + KSWZ(rr_, 256 + rc_ * 2)) = kr0; } while (0)
#define SWAIT() asm volatile("s_waitcnt vmcnt(0)" ::: "memory")
#define RESC(a) do { if (__any((a) < 1.f)) { if (hi == 0) al_l[r32] = (a); asm volatile("s_waitcnt lgkmcnt(0)" ::: "memory"); \
    _Pragma("unroll") for (int d = 0; d < 4; ++d) _Pragma("unroll") for (int r = 0; r < 16; ++r) o[d][r] *= al_l[crow(r, hi)]; } } while (0)
  f32x16 pA0, pA1; float mnA, alA; bf16x8 pa0, pa1, pa2, pa3; const int NTL = seq / KVBLK;
  SLOAD(0); SWAIT(); SWRITE(0); __syncthreads();
  for (int j = 0; j < NTL; ++j) {
    const int cur = j & 1;
    if (j + 1 < NTL) SLOAD((j + 1) * KVBLK);
    SBAR(); qkt(pA0, pA1, K_lds + cur * SHM_K, qr, r32, hi);
    partialSM(pA0, pA1, m_reg, mnA, alA);
    RESC(alA);
    finishSM(pA0, pA1, alA, l_reg, pa0, pa1, pa2, pa3); SBAR();
    pv_d0(o, vb0 + cur * SHM_V, pa0, pa1, pa2, pa3);
    if (j + 1 < NTL) { SWAIT(); SWRITE(cur ^ 1); }
    __syncthreads();
  }
  if (hi == 0) li_l[r32] = l_reg; asm volatile("s_waitcnt lgkmcnt(0)" ::: "memory");
  u16* Ow = Ob + (size_t)(wid * 32) * 1024;
  unsigned voff = hi * 4096 + r32;
  asm volatile("" : "+v"(voff));
#pragma unroll
  for (int r = 0; r < 16; ++r) { const int cr = (r & 3) + 8 * (r >> 2); float rl = __builtin_amdgcn_rcpf(li_l[cr + 4 * hi]);
    u16* rowp = Ow + cr * 1024;
#pragma unroll
    for (int d0 = 0; d0 < 4; ++d0) rowp[voff + d0 * 32] = f2bf(o[d0][r] * rl); }
  asm volatile("s_waitcnt vmcnt(0) lgkmcnt(0)" ::: "memory");
  __syncthreads();
#undef SLOAD
#undef SWRITE
#undef SWAIT
#undef RESC
}

DEV void attn_phase(const Params& p, bool need_ctx, int vb, int G, char* lds) {
  const u16* q = reinterpret_cast<const u16*>(p.ws + WS_R);
  const u16* kv = q + (size_t)MROWS * 1536;
  const u16* krope = reinterpret_cast<const u16*>(p.ws + WS_Y) + (size_t)MROWS * (384 + 256);
  u16* ob = reinterpret_cast<u16*>(p.ws + WS_H);
  const int nitems = 1024 + (need_ctx ? 32 : 0);
  if (__builtin_amdgcn_readfirstlane((int)(threadIdx.x >> 6)) >= 4) __builtin_amdgcn_s_setprio(1);
  for (int it = vb; it < nitems; it += G) {
    int bh, qrow0, seq;
    if (it < 1024) { bh = it >> 5; qrow0 = CTX + (it & 31) * 256; seq = TT; }
    else { bh = it - 1024; qrow0 = 0; seq = CTX; }
    const int b = bh >> 3, h = bh & 7;
    const size_t r0 = (size_t)b * TT;
    attn_body(q + (r0 + qrow0) * 1536 + h * 192, kv + r0 * 2048 + h * 256, krope + r0 * 64, kv + r0 * 2048 + h * 256 + 128,
              ob + (r0 + qrow0) * 1024 + h * 128, seq, lds);
  }
  __builtin_amdgcn_s_setprio(0);
}

DEV void gla_scan(const Params& p, int lj, int vb, int G, char* lds) {
  int tid = threadIdx.x; asm volatile("" : "+v"(tid)); const int lane = tid & 63, w = tid >> 6, l15 = lane & 15, lq = lane >> 4;
  const u16* qk = reinterpret_cast<const u16*>(p.ws + WS_R);
  const u16* vbuf = qk + (size_t)MROWS * 1024;
  const float* gl = reinterpret_cast<const float*>(p.ws + WS_R + (size_t)MROWS * 1024 * 2 * 3);
  u16* rawQ = reinterpret_cast<u16*>(lds); u16* rawK = reinterpret_cast<u16*>(lds + 16384); u16* rawV = reinterpret_cast<u16*>(lds + 32768);
  float* glS = reinterpret_cast<float*>(lds + 36864);
  char* qt = lds + 40960; char* kt = lds + 57344; char* kendT = lds + 73728; char* vT = lds + 90112; char* Ab = lds + 94208; char* ST = lds + 102400;
  float* decS = reinterpret_cast<float*>(lds + 110592); float* gsum = reinterpret_cast<float*>(lds + 111104);
  const int d = tid & 127, ig = tid >> 7;
  for (int u = vb; u < 256; u += G) {
    const int s = u & 7, dir = (u >> 3) & 1, h = (u >> 4) & 3, b = u >> 6;
    u16* odir = reinterpret_cast<u16*>(p.ws + (dir == 0 ? WS_H : WS_Y));
    const int dg = w * 16 + l15;
    bf16x8 w2f;
    { float wv_[8];
#pragma unroll
      for (int jj = 0; jj < 8; ++jj) { const int r = (lq & 1) * 8 + jj;
        const float v = p.gla_w_gate2[((size_t)(lj * 2 + dir) * 16 + r) * 512 + h * 128 + dg]; wv_[jj] = (lq < 2) ? v : 0.f; }
      u32x4 wv4 = {cvtpk(wv_[0], wv_[1]), cvtpk(wv_[2], wv_[3]), cvtpk(wv_[4], wv_[5]), cvtpk(wv_[6], wv_[7])};
      w2f = *reinterpret_cast<bf16x8*>(&wv4); }
    const float bias = p.gla_b_gate[(size_t)(lj * 2 + dir) * 512 + h * 128 + dg];
    f32x4 Sacc[2] = {f32x4{0, 0, 0, 0}, f32x4{0, 0, 0, 0}};
    __syncthreads();
    *reinterpret_cast<u32x4*>(ST + tid * 16) = u32x4{0, 0, 0, 0};
    bf16x8 pq[2], pk[2]; u32x4 pv;
    auto rowof = [&](int n, int i) -> size_t { int pp = n * 64 + i; int t = (dir == 0) ? pp : (pp < CTX ? (CTX - 1 - pp) : (TT + CTX - 1 - pp)); return (size_t)b * TT + t; };
    auto gload = [&](int n) {
#pragma unroll
      for (int x = 0; x < 2; ++x) { int c = tid + x * 512, i = c >> 4, ch = c & 15; size_t row = rowof(n, i);
        pq[x] = *reinterpret_cast<const bf16x8*>(qk + row * 1024 + h * 128 + ch * 8);
        pk[x] = *reinterpret_cast<const bf16x8*>(qk + row * 1024 + 512 + h * 128 + ch * 8); }
      if (tid < 256) { int i = tid >> 2, ch = tid & 3; pv = *reinterpret_cast<const u32x4*>(vbuf + rowof(n, i) * 1024 + h * 256 + s * 32 + ch * 8); }
      else { int i = (tid - 256) >> 2, ch = tid & 3; pv = *reinterpret_cast<const u32x4*>(gl + rowof(n, i) * 32 + dir * 16 + ch * 4); }
    };
    auto lstore = [&]() {
#pragma unroll
      for (int x = 0; x < 2; ++x) { int c = tid + x * 512, i = c >> 4, ch = c & 15;
        *reinterpret_cast<bf16x8*>(rawQ + i * 128 + ch * 8) = pq[x]; *reinterpret_cast<bf16x8*>(rawK + i * 128 + ch * 8) = pk[x]; }
      if (tid < 256) { int i = tid >> 2, ch = tid & 3; *reinterpret_cast<u32x4*>(rawV + i * 32 + ch * 8) = pv; }
      else { int i = (tid - 256) >> 2, ch = tid & 3; *reinterpret_cast<u32x4*>(glS + i * 16 + ch * 4) = pv; }
    };
    gload(0); lstore();
    const int it = w >> 1, wv = w & 1;
    for (int n = 0; n < 132; ++n) {
      VM_DRAIN();
      __syncthreads();
      if (n + 1 < 132) gload(n + 1);
      float gq[4][4];
#pragma unroll
      for (int tt = 0; tt < 4; ++tt) {
        const float* gp = glS + (tt * 16 + l15) * 16 + (lq & 1) * 8;
        f32x4 g0 = *reinterpret_cast<const f32x4*>(gp), g1 = *reinterpret_cast<const f32x4*>(gp + 4);
        if (lq >= 2) { g0 = f32x4{0, 0, 0, 0}; g1 = f32x4{0, 0, 0, 0}; }
        u32x4 ga = {cvtpk(g0[0], g0[1]), cvtpk(g0[2], g0[3]), cvtpk(g1[0], g1[1]), cvtpk(g1[2], g1[3])};
        f32x4 xa = mfma16(*reinterpret_cast<bf16x8*>(&ga), w2f, f32x4{0, 0, 0, 0});
#pragma unroll
        for (int j = 0; j < 4; ++j) { const float xg = xa[j] + bias;
          gq[tt][j] = (fminf(xg, 0.f) - __logf(1.f + __expf(-fabsf(xg)))) * (1.f / 16.f); }
      }
      float base = 0.f, tot = 0.f;
#pragma unroll
      for (int tt = 0; tt < 4; ++tt) {
        gq[tt][1] += gq[tt][0]; gq[tt][2] += gq[tt][1]; gq[tt][3] += gq[tt][2];
        const float T = gq[tt][3];
        const float u1 = __shfl(T, (lane - 16) & 63), u2 = __shfl(T, (lane - 32) & 63), u3 = __shfl(T, (lane - 48) & 63);
        const float E = (lq >= 1 ? u1 : 0.f) + (lq >= 2 ? u2 : 0.f) + (lq >= 3 ? u3 : 0.f);
        float S = T + __shfl_xor(T, 16); S += __shfl_xor(S, 32);
#pragma unroll
        for (int j = 0; j < 4; ++j) gq[tt][j] += base + E;
        base += S;
      }
      tot = base;
      if (lq == 0) decS[dg] = __expf(tot);
#pragma unroll
      for (int tt = 0; tt < 4; ++tt) {
        float ke[4];
#pragma unroll
        for (int j = 0; j < 4; ++j) {
          const int i = tt * 16 + lq * 4 + j; const float Gv = gq[tt][j];
          const float qv = bf2f(rawQ[i * 128 + dg]), kvv = bf2f(rawK[i * 128 + dg]);
          *reinterpret_cast<u16*>(qt + off256(i, dg >> 3) + (dg & 7) * 2) = f2bf(qv * __expf(Gv));
          *reinterpret_cast<u16*>(kt + off256(i, dg >> 3) + (dg & 7) * 2) = f2bf(kvv * __expf(-Gv));
          ke[j] = kvv * __expf(tot - Gv);
        }
        *reinterpret_cast<u32x2*>(kendT + off128(dg, tt * 2 + (lq >> 1)) + (lq & 1) * 8) = u32x2{cvtpk(ke[0], ke[1]), cvtpk(ke[2], ke[3])};
      }
      { const int vc = tid & 31, jg = tid >> 5;
        unsigned a0 = rawV[(jg * 4 + 0) * 32 + vc], a1 = rawV[(jg * 4 + 1) * 32 + vc], a2 = rawV[(jg * 4 + 2) * 32 + vc], a3 = rawV[(jg * 4 + 3) * 32 + vc];
        *reinterpret_cast<u32x2*>(vT + off128(vc, jg >> 1) + (jg & 1) * 8) = u32x2{a0 | (a1 << 16), a2 | (a3 << 16)}; }
      __syncthreads();
      if (n + 1 < 132) lstore();
      f32x4 oacc = f32x4{0, 0, 0, 0};
      bf16x8 qa[4];
#pragma unroll
      for (int ks = 0; ks < 4; ++ks) qa[ks] = *reinterpret_cast<const bf16x8*>(qt + off256(it * 16 + l15, ks * 4 + lq));
#pragma unroll
      for (int ks = 0; ks < 4; ++ks) { bf16x8 bb = *reinterpret_cast<const bf16x8*>(ST + off256(wv * 16 + l15, ks * 4 + lq)); oacc = mfma16(qa[ks], bb, oacc); }
#pragma unroll
      for (int x = 0; x < 2; ++x) {
        const int jt = wv * 2 + x; f32x4 aacc = f32x4{0, 0, 0, 0};
        if (jt <= it) {
#pragma unroll
          for (int ks = 0; ks < 4; ++ks) { bf16x8 bb = *reinterpret_cast<const bf16x8*>(kt + off256(jt * 16 + l15, ks * 4 + lq)); aacc = mfma16(qa[ks], bb, aacc); }
        }
#pragma unroll
        for (int jj = 0; jj < 4; ++jj) { const int i = it * 16 + lq * 4 + jj, j = jt * 16 + l15;
          *reinterpret_cast<u16*>(Ab + off128(i, j >> 3) + (j & 7) * 2) = f2bf(j <= i ? aacc[jj] : 0.f); }
      }
      __syncthreads();
#pragma unroll
      for (int ks = 0; ks < 2; ++ks) { bf16x8 a = *reinterpret_cast<const bf16x8*>(Ab + off128(it * 16 + l15, ks * 4 + lq));
        bf16x8 bb = *reinterpret_cast<const bf16x8*>(vT + off128(wv * 16 + l15, ks * 4 + lq)); oacc = mfma16(a, bb, oacc); }
#pragma unroll
      for (int jj = 0; jj < 4; ++jj) { const int i = it * 16 + lq * 4 + jj;
        odir[rowof(n, i) * 1024 + h * 256 + s * 32 + wv * 16 + l15] = f2bf(oacc[jj]); }
      f32x4 dv = *reinterpret_cast<const f32x4*>(decS + w * 16 + lq * 4);
      bf16x8 ka[2];
#pragma unroll
      for (int ks = 0; ks < 2; ++ks) ka[ks] = *reinterpret_cast<const bf16x8*>(kendT + off128(w * 16 + l15, ks * 4 + lq));
#pragma unroll
      for (int vt = 0; vt < 2; ++vt) {
        Sacc[vt] = Sacc[vt] * dv;
#pragma unroll
        for (int ks = 0; ks < 2; ++ks) { bf16x8 bb = *reinterpret_cast<const bf16x8*>(vT + off128(vt * 16 + l15, ks * 4 + lq)); Sacc[vt] = mfma16(ka[ks], bb, Sacc[vt]); }
        *reinterpret_cast<u32x2*>(ST + off256(vt * 16 + l15, w * 2 + (lq >> 1)) + (lq & 1) * 8) = u32x2{cvtpk(Sacc[vt][0], Sacc[vt][1]), cvtpk(Sacc[vt][2], Sacc[vt][3])};
      }
    }
  }
}

DEV void gla_out_pass(const Params& p, int lj) {
  const int tid_ = tidx(); const int lane = tid_ & 63;
  const int gw = blockIdx.x * 8 + (tid_ >> 6), nw = gridDim.x * 8;
  u16* of = reinterpret_cast<u16*>(p.ws + WS_H);
  const u16* ob = reinterpret_cast<const u16*>(p.ws + WS_Y);
  const u16* rb = reinterpret_cast<const u16*>(p.ws + WS_R) + (size_t)MROWS * 2048;
  float go[16];
#pragma unroll
  for (int j = 0; j < 4; ++j) { float4 g4 = *reinterpret_cast<const float4*>(p.gla_g_o + lj * 256 + (lane & 15) * 16 + j * 4); go[j * 4] = g4.x; go[j * 4 + 1] = g4.y; go[j * 4 + 2] = g4.z; go[j * 4 + 3] = g4.w; }
  for (int m = gw; m < MROWS; m += nw) {
    const size_t base = (size_t)m * 1024 + lane * 16;
    u32x4 f0 = *reinterpret_cast<const u32x4*>(of + base), f1 = *reinterpret_cast<const u32x4*>(of + base + 8);
    u32x4 b0 = *reinterpret_cast<const u32x4*>(ob + base), b1 = *reinterpret_cast<const u32x4*>(ob + base + 8);
    u32x4 r0 = *reinterpret_cast<const u32x4*>(rb + base), r1 = *reinterpret_cast<const u32x4*>(rb + base + 8);
    float o[16], rr[16];
#pragma unroll
    for (int j = 0; j < 4; ++j) {
      o[2 * j] = bflo(f0[j]) + bflo(b0[j]); o[2 * j + 1] = bfhi(f0[j]) + bfhi(b0[j]);
      o[8 + 2 * j] = bflo(f1[j]) + bflo(b1[j]); o[8 + 2 * j + 1] = bfhi(f1[j]) + bfhi(b1[j]);
      rr[2 * j] = bflo(r0[j]); rr[2 * j + 1] = bfhi(r0[j]); rr[8 + 2 * j] = bflo(r1[j]); rr[8 + 2 * j + 1] = bfhi(r1[j]);
    }
    float ss = 0;
#pragma unroll
    for (int j = 0; j < 16; ++j) ss += o[j] * o[j];
    ss += __shfl_xor(ss, 8); ss += __shfl_xor(ss, 4); ss += __shfl_xor(ss, 2); ss += __shfl_xor(ss, 1);
    const float rs = rsqrtf(ss * (1.f / 256.f) + EPS);
    float y[16];
#pragma unroll
    for (int j = 0; j < 16; ++j) y[j] = (o[j] * rs * go[j]) * rr[j];
    u32x4 w0 = {cvtpk(y[0], y[1]), cvtpk(y[2], y[3]), cvtpk(y[4], y[5]), cvtpk(y[6], y[7])};
    u32x4 w1 = {cvtpk(y[8], y[9]), cvtpk(y[10], y[11]), cvtpk(y[12], y[13]), cvtpk(y[14], y[15])};
    *reinterpret_cast<u32x4*>(of + base) = w0; *reinterpret_cast<u32x4*>(of + base + 8) = w1;
    VM_DRAIN();
  }
}

#define XB_TMO      128
#define XB_XCNT(j)  (256  + 64 * (j))
#define XB_XSUB(j)  (1280 + 64 * (j))
#define XB_XGEN(j)  (2304 + 64 * (j))
#define XB_TOP      3328
#define XB_TOPGEN   3392
#define XCD_BAR_WORDS 3456
#define XB_SPIN_CAP (1u << 18)
#define LAS __attribute__((address_space(3)))

__device__ __forceinline__ unsigned xb_ld(unsigned* p)              { return __hip_atomic_load(p, __ATOMIC_RELAXED, __HIP_MEMORY_SCOPE_AGENT); }
__device__ __forceinline__ unsigned xb_add(unsigned* p, unsigned v) { return __hip_atomic_fetch_add(p, v, __ATOMIC_RELAXED, __HIP_MEMORY_SCOPE_AGENT); }
__device__ __forceinline__ unsigned xb_xcc_id() { return (unsigned)__builtin_amdgcn_s_getreg((3 << 11) | 20) & 0xFu; }
#define XB_SPIN(cond, bar) do { unsigned _sp = 0; while (cond) { __builtin_amdgcn_s_sleep(1); \
    if ((++_sp & 255u) == 0u) { if (xb_ld(&(bar)[XB_TMO])) break; if (_sp > XB_SPIN_CAP) { atomicAdd(&(bar)[XB_TMO], 1u); break; } } } } while (0)

struct XcdBarrier {
    unsigned* bar; unsigned x;
    volatile LAS unsigned* st;
};

__device__ __forceinline__ XcdBarrier xcd_barrier_post(unsigned* bar, volatile LAS unsigned* st) {
    XcdBarrier b; b.bar = bar; b.x = xb_xcc_id(); b.st = st;
    if (threadIdx.x == 0) (void)xb_add(&bar[XB_XCNT(b.x)], 1u);
    return b;
}
__device__ __forceinline__ void xcd_barrier_complete(unsigned* bar, unsigned x, unsigned& nloc, unsigned& nx) {
    const unsigned G = gridDim.x * gridDim.y * gridDim.z;
    unsigned sum, cnt, mine, sp = 0u;
    for (;;) {
        sum = 0u; cnt = 0u; mine = 0u;
#pragma unroll
        for (unsigned j = 0; j < 16; ++j) { const unsigned c = xb_ld(&bar[XB_XCNT(j)]); sum += c; cnt += (c > 0u) ? 1u : 0u; mine = (j == x) ? c : mine; }
        if (sum == G) break;
        __builtin_amdgcn_s_sleep(1);
        if ((++sp & 255u) == 0u) { if (xb_ld(&bar[XB_TMO])) break; if (sp > XB_SPIN_CAP) { atomicAdd(&bar[XB_TMO], 1u); break; } }
    }
    nloc = mine > 0u ? mine : 1u; nx = cnt > 0u ? cnt : 1u;
}

__device__ __forceinline__ void xcd_barrier(const XcdBarrier& b) {
    asm volatile("s_waitcnt vmcnt(0)" ::: "memory");
    __syncthreads();
    if (threadIdx.x == 0) {
        unsigned* bar = b.bar;
        __builtin_amdgcn_s_waitcnt(0);
        unsigned nloc = b.st[0], nx = b.st[1];
        if (nloc == 0u) { xcd_barrier_complete(bar, b.x, nloc, nx); b.st[0] = nloc; b.st[1] = nx; }
        const unsigned old = xb_add(&bar[XB_XSUB(b.x)], 1u);
        const unsigned gen = old / nloc;
        if (old + 1u == (gen + 1u) * nloc) {
            __builtin_amdgcn_fence(__ATOMIC_RELEASE, "agent");
            asm volatile("s_waitcnt vmcnt(0)" ::: "memory");
            const unsigned og = xb_add(&bar[XB_TOP], 1u);
            const unsigned tg = og / nx;
            if (og + 1u == (tg + 1u) * nx) xb_add(&bar[XB_TOPGEN], 1u);
            else XB_SPIN(xb_ld(&bar[XB_TOPGEN]) == tg, bar);
            __builtin_amdgcn_fence(__ATOMIC_ACQUIRE, "agent");
            xb_add(&bar[XB_XGEN(b.x)], 1u);
            asm volatile("s_waitcnt vmcnt(0)" ::: "memory");
        } else {
            XB_SPIN(xb_ld(&bar[XB_XGEN(b.x)]) == gen, bar);
            __builtin_amdgcn_fence(__ATOMIC_ACQUIRE, "agent");
            asm volatile("s_waitcnt vmcnt(0)" ::: "memory");
        }
    }
    __syncthreads();
}

__global__ void __launch_bounds__(NTHR) mega(Params p, int ph_lo, int ph_hi) {
  extern __shared__ __attribute__((aligned(16))) char lds[];
  cg::grid_group grid = cg::this_grid();
#define GSYNC() do { asm volatile("s_waitcnt vmcnt(0) lgkmcnt(0)" ::: "memory"); __syncthreads(); grid.sync(); __builtin_amdgcn_fence(__ATOMIC_ACQUIRE, "agent"); asm volatile("s_waitcnt vmcnt(0) lgkmcnt(0)" ::: "memory"); __syncthreads(); } while (0)
  const int G = gridDim.x;
  unsigned* bar = reinterpret_cast<unsigned*>(p.ws + WS_STAT);
  volatile LAS unsigned* xst = (volatile LAS unsigned*)(LAS char*)(lds + 149504);
  if (threadIdx.x == 0) { xst[0] = 0u; xst[1] = 0u; }
  __syncthreads();
  XcdBarrier xbar = xcd_barrier_post(bar, xst);
  const int vb = ((G & 7) == 0) ? (int)((blockIdx.x & 7) * (G >> 3) + (blockIdx.x >> 3)) : (int)blockIdx.x;
#define W_ reinterpret_cast<u16*>(p.ws + WS_W)
#define hbuf reinterpret_cast<u16*>(p.ws + WS_H)
#define ybuf reinterpret_cast<u16*>(p.ws + WS_Y)
#define rbuf reinterpret_cast<u16*>(p.ws + WS_R)
#define wmlp (W_ + OFF_WMLP + (size_t)layer * SZ_MLP)
#define wm (W_ + OFF_WMLA + (size_t)j * SZ_MLA)
#define wg (W_ + OFF_WGLA + (size_t)j * SZ_GLA)
#define cq ybuf
#define ckv (ybuf + (size_t)MROWS * 384)
#define krope (ybuf + (size_t)MROWS * 640)
#define qb rbuf
#define kvb (rbuf + (size_t)MROWS * 1536)
#pragma unroll 1
  for (int ph = ph_lo; ph < ph_hi; ++ph) {
    if (ph == 0) {
      phase0(p, vb, G, lds);
    } else if (ph == 33) {
      row_pass(p, 3, 5, 3, -1, 0, 0, 0, false, true);
    } else {
      const int layer = (ph - 1) >> 3, sub = (ph - 1) & 7, j = layer >> 1;
      const bool mla = (layer & 1) == 0;
      if (sub == 0) {
        row_pass(p, layer > 0 ? layer - 1 : -1, 5, 3, layer, 0, 1, 0, layer == 0, false);
      } else if (sub == 1) {
        if (mla) { Epi e{cq, ckv, krope, nullptr, nullptr, nullptr, nullptr};
          gemm_phase<E_MLA1>(hbuf, 1024, wm, 1024, 768, 0, vb, G, lds, e); }
        else { Epi e{rbuf, rbuf + (size_t)MROWS * 1024, rbuf + (size_t)MROWS * 2048, reinterpret_cast<float*>(rbuf + (size_t)MROWS * 3072), nullptr, nullptr, nullptr};
          gemm_phase<E_GLA1>(hbuf, 1024, wg, 1024, 3200, 0, vb, G, lds, e); }
      } else if (sub == 2) {
        if (mla) {
          { Epi e{qb, nullptr, nullptr, nullptr, nullptr, nullptr, nullptr};
            gemm_phase<E_MLAQ>(cq, 384, wm + SZ_MLA_W1, 384, 1536, 0, vb, G, lds, e); }
          { Epi e{kvb, nullptr, nullptr, nullptr, nullptr, nullptr, nullptr};
            gemm_phase<E_MLAKV>(ckv, 256, wm + SZ_MLA_W1 + SZ_MLA_UQ, 256, 2048, 132 * 12, vb, G, lds, e); }
        } else {
          gla_scan(p, j, vb, G, lds);
        }
      } else if (sub == 3) {
        if (mla) attn_phase(p, layer < 3, vb, G, lds);
        else gla_out_pass(p, j);
      } else if (sub == 4) {
        Epi e{ybuf, nullptr, nullptr, nullptr, nullptr, nullptr, nullptr};
        gemm_phase<E_Y, 3>(hbuf, 1024, mla ? wm + SZ_MLA_W1 + SZ_MLA_UQ + SZ_MLA_UKV : wg + SZ_GLA_W1, 1024, 1024, 0, vb, G, lds, e);
      } else if (sub == 5) {
        row_pass(p, layer, 2, 1, layer, 3, 4, 2, false, false);
      } else if (sub == 6) {
        Epi e{rbuf, nullptr, nullptr, nullptr, nullptr, nullptr, nullptr};
        gemm_phase<E_MLP1>(hbuf, 1024, wmlp, 1024, 4096, 0, vb, G, lds, e);
      } else {
        Epi e{ybuf, nullptr, nullptr, nullptr, nullptr, nullptr, nullptr};
        gemm_phase<E_Y, 3>(rbuf, 4096, wmlp + SZ_MLP1, 4096, 1024, 0, vb, G, lds, e);
      }
    }
    if (ph + 1 < ph_hi) {
      if (ph_hi < 0) { GSYNC(); }
      {
        asm volatile("s_waitcnt vmcnt(0) lgkmcnt(0)" ::: "memory");
        xcd_barrier(xbar);
      }
    }
  }
}

#undef W_
#undef hbuf
#undef ybuf
#undef rbuf
#undef wmlp
#undef wm
#undef wg
#undef cq
#undef ckv
#undef krope
#undef qb
#undef kvb
#ifndef N_SPLIT
#define N_SPLIT 1
#endif
extern "C" void kernel_launch(void* const* d_in, const int* in_sizes, int n_in, void* d_out, int out_size, void* d_ws, size_t ws_size, hipStream_t stream) {
  static int grid_blocks = 0;
  if (grid_blocks == 0) {
    if (n_in != 25 || ws_size < WS_END) { fprintf(stderr, "kernel_launch: bad inputs n_in %d ws %zu need %zu\n", n_in, ws_size, (size_t)WS_END); grid_blocks = -1; return; }
    int dev = 0, cus = 0, per_cu = 0;
    (void)hipGetDevice(&dev);
    (void)hipDeviceGetAttribute(&cus, hipDeviceAttributeMultiprocessorCount, dev);
    if (hipFuncSetAttribute((const void*)mega, hipFuncAttributeMaxDynamicSharedMemorySize, LDS_BYTES) != hipSuccess) { fprintf(stderr, "kernel_launch: set LDS attr failed\n"); grid_blocks = -1; return; }
    if (hipOccupancyMaxActiveBlocksPerMultiprocessor(&per_cu, (const void*)mega, NTHR, LDS_BYTES) != hipSuccess || per_cu < 1) { fprintf(stderr, "kernel_launch: occupancy query failed (%d)\n", per_cu); per_cu = 1; }
    (void)hipGetLastError();
    grid_blocks = cus;
  }
  if (grid_blocks < 0) return;
  Params p{};
  const float** pf = reinterpret_cast<const float**>(&p);
  for (int i = 0; i < 25; ++i) pf[i] = (const float*)d_in[i];
  p.out = (float*)d_out; p.ws = (unsigned char*)d_ws;
#ifdef SEQ_LIST
  const int seq_[] = SEQ_LIST;
  for (int li = 0; li < (int)(sizeof(seq_) / sizeof(int)); ++li) {
    int lo = seq_[li], hi = lo + 1;
#else
  (void)hipMemsetAsync((unsigned char*)d_ws + WS_STAT, 0, 16384, stream);
  for (int li = 0; li < N_SPLIT; ++li) {
    int lo = (34 * li) / N_SPLIT, hi = (34 * (li + 1)) / N_SPLIT;
#endif
    void* args[] = {&p, &lo, &hi};
    hipError_t e = hipLaunchCooperativeKernel((const void*)mega, dim3(grid_blocks), dim3(NTHR), args, LDS_BYTES, stream);
    if (e != hipSuccess) { fprintf(stderr, "cooperative launch failed: %s (grid %d)\n", hipGetErrorString(e), grid_blocks); break; }
  }
}
```

```cpp
#include <hip/hip_runtime.h>
#include <hip/hip_cooperative_groups.h>
#include <stdint.h>
#include <cstdio>
namespace cg = cooperative_groups;

typedef unsigned short u16;
using bf16x8 = __attribute__((ext_vector_type(8))) short;
using s16x4  = __attribute__((ext_vector_type(4))) short;
using f32x4  = __attribute__((ext_vector_type(4))) float;
using f32x16 = __attribute__((ext_vector_type(16))) float;
using u32x4  = __attribute__((ext_vector_type(4))) unsigned;
using u32x2  = __attribute__((ext_vector_type(2))) unsigned;
#define DEV __device__ __forceinline__

constexpr int DM = 1024, NBATCH = 4, SEQ = 8192, CTX = 256, TT = SEQ + CTX, MROWS = NBATCH * TT;
constexpr int NTHR = 512;
constexpr float EPS = 1e-6f;

struct Params {
  const float *x, *c, *ctx, *c_ctx, *ada_w, *ada_b, *norm_g, *mlp_w1, *mlp_w2,
      *mla_w_dq, *mla_g_q, *mla_w_uq, *mla_w_dkv, *mla_g_kv, *mla_w_ukv, *mla_w_o,
      *gla_w_q, *gla_w_k, *gla_w_v, *gla_w_r, *gla_w_gate1, *gla_w_gate2, *gla_b_gate, *gla_g_o, *gla_w_o;
  float* out;
  unsigned char* ws;
};

constexpr size_t SZ_MLA_W1 = 768 * 1024, SZ_MLA_UQ = 1536 * 384, SZ_MLA_UKV = 2048 * 256, SZ_WO = 1024 * 1024;
constexpr size_t SZ_MLA = SZ_MLA_W1 + SZ_MLA_UQ + SZ_MLA_UKV + SZ_WO;
constexpr size_t SZ_GLA_W1 = 3200 * 1024, SZ_GLA = SZ_GLA_W1 + SZ_WO;
constexpr size_t SZ_MLP1 = 4096 * 1024, SZ_MLP = 2 * SZ_MLP1;
constexpr size_t OFF_WMLA = 0, OFF_WGLA = 2 * SZ_MLA, OFF_WMLP = OFF_WGLA + 2 * SZ_GLA, W_TOTAL = OFF_WMLP + 4 * SZ_MLP;
constexpr size_t WS_W = 0;
constexpr size_t WS_MOD = WS_W + W_TOTAL * 2;
constexpr size_t WS_XCTX = WS_MOD + 4 * 5 * 6144 * 4;
constexpr size_t WS_STAT = WS_XCTX + (size_t)NBATCH * CTX * DM * 4;
constexpr size_t WS_H = WS_STAT + 4 * (size_t)MROWS * 4;
constexpr size_t WS_Y = WS_H + (size_t)MROWS * 1024 * 2;
constexpr size_t WS_R = WS_Y + (size_t)MROWS * 1024 * 2;
constexpr size_t WS_END = WS_R + (size_t)MROWS * 4096 * 2;
static_assert(WS_MOD % 256 == 0 && WS_H % 256 == 0 && WS_R % 256 == 0, "align");

constexpr int LDS_BYTES = 149520;

DEV u16 f2bf(float f) { unsigned u = __float_as_uint(f); u += 0x7fffu + ((u >> 16) & 1u); return (u16)(u >> 16); }
DEV float bf2f(u16 h) { return __uint_as_float(((unsigned)h) << 16); }
typedef __bf16 bf16x2_t __attribute__((ext_vector_type(2)));
DEV unsigned cvtpk(float lo, float hi) { bf16x2_t v = {(__bf16)lo, (__bf16)hi}; return __builtin_bit_cast(unsigned, v); }
DEV float bflo(unsigned u) { return __uint_as_float(u << 16); }
DEV float bfhi(unsigned u) { return __uint_as_float(u & 0xffff0000u); }
DEV int off128(int row, int ch) { return row * 128 + ((ch ^ ((row >> 1) & 7)) << 4); }
DEV int off256(int row, int ch) { return row * 256 + ((ch ^ (row & 15)) << 4); }
DEV f32x4 mfma16(bf16x8 a, bf16x8 b, f32x4 c) { return __builtin_amdgcn_mfma_f32_16x16x32_bf16(a, b, c, 0, 0, 0); }
DEV float wave_sum(float v) {
  v += __shfl_xor(v, 32); v += __shfl_xor(v, 16); v += __shfl_xor(v, 8); v += __shfl_xor(v, 4); v += __shfl_xor(v, 2); v += __shfl_xor(v, 1);
  return v;
}
#define VM_DRAIN() do { } while (0)
DEV int tidx() { int t = threadIdx.x; asm volatile("" : "+v"(t)); return t; }
DEV float silu_f(float v) { return v / (1.f + __expf(-v)); }
DEV void rope_sc(float pos, int f, float& sn, float& cs) {
  float invf = exp2f(-(float)f * 0.8304820237218406f);
  float rev = pos * invf * 0.15915494309189535f;
  rev = rev - floorf(rev);
  sn = __builtin_amdgcn_sinf(rev); cs = __builtin_amdgcn_cosf(rev);
}
#define rope_rot(A_, B_, POS_, F_) do { float sn_, cs_; rope_sc(POS_, F_, sn_, cs_); float a_ = (A_), b_ = (B_); (A_) = a_ * cs_ - b_ * sn_; (B_) = a_ * sn_ + b_ * cs_; } while (0)

DEV void tr_job(const float* __restrict__ src, int K, int N, u16* __restrict__ dst, const float* __restrict__ kscale, float scalar,
                int& rot, int vb, int G, float* tile) {
  const int tid = tidx();
  const int tn = N >> 6, tk = K >> 6, ntl = tn * tk;
  int start = (vb - (rot % G) + G) % G;
  for (int t = start; t < ntl; t += G) {
    int kb = t / tn, nb = t - kb * tn;
#pragma unroll
    for (int i = 0; i < 2; ++i) {
      int idx = tid + i * 512, r = idx >> 4, c4 = idx & 15;
      float4 v = *reinterpret_cast<const float4*>(src + (size_t)(kb * 64 + r) * N + nb * 64 + c4 * 4);
      float s = scalar * (kscale ? kscale[kb * 64 + r] : 1.f);
      float* tp = tile + r * 65 + c4 * 4;
      tp[0] = v.x * s; tp[1] = v.y * s; tp[2] = v.z * s; tp[3] = v.w * s;
    }
    __syncthreads();
    {
      int n = tid >> 3, k8 = (tid & 7) * 8;
      float e[8];
#pragma unroll
      for (int j = 0; j < 8; ++j) e[j] = tile[(k8 + j) * 65 + n];
      u32x4 w = {cvtpk(e[0], e[1]), cvtpk(e[2], e[3]), cvtpk(e[4], e[5]), cvtpk(e[6], e[7])};
      *reinterpret_cast<u32x4*>(dst + (size_t)(nb * 64 + n) * K + kb * 64 + k8) = w;
    }
    VM_DRAIN();
    __syncthreads();
  }
  rot += ntl;
}

DEV void phase0(const Params& p, int vb, int G, char* lds) {
  const int tid = tidx();
  u16* W = reinterpret_cast<u16*>(p.ws + WS_W);
  float* mod = reinterpret_cast<float*>(p.ws + WS_MOD);
  float* sc = reinterpret_cast<float*>(lds);
  float* red = sc + 5 * 1024;
  float* tile = red + 8 * 5 * 64;
  for (int idx = tid; idx < 5 * 1024; idx += NTHR) {
    int w = idx >> 10, k = idx & 1023;
    float v = (w < 4) ? p.c[w * 1024 + k] : p.c_ctx[k];
    sc[idx] = silu_f(v);
  }
  __syncthreads();
  for (int u = vb; u < 384; u += G) {
    int i = u / 96, n0 = (u - i * 96) * 64, cgi = tid & 63, kg = tid >> 6;
    float a0 = 0, a1 = 0, a2 = 0, a3 = 0, a4 = 0;
    const float* wp = p.ada_w + ((size_t)i * 1024 + kg * 128) * 6144 + n0 + cgi;
#pragma unroll 8
    for (int k = 0; k < 128; ++k) {
      float w = wp[(size_t)k * 6144];
      int kk = kg * 128 + k;
      a0 += sc[kk] * w; a1 += sc[1024 + kk] * w; a2 += sc[2048 + kk] * w; a3 += sc[3072 + kk] * w; a4 += sc[4096 + kk] * w;
    }
    red[(kg * 5 + 0) * 64 + cgi] = a0; red[(kg * 5 + 1) * 64 + cgi] = a1; red[(kg * 5 + 2) * 64 + cgi] = a2;
    red[(kg * 5 + 3) * 64 + cgi] = a3; red[(kg * 5 + 4) * 64 + cgi] = a4;
    __syncthreads();
    if (tid < 320) {
      int w5 = tid >> 6, cc = tid & 63;
      float s = p.ada_b[i * 6144 + n0 + cc];
#pragma unroll
      for (int g = 0; g < 8; ++g) s += red[(g * 5 + w5) * 64 + cc];
      mod[(size_t)(i * 5 + w5) * 6144 + n0 + cc] = s;
    }
    VM_DRAIN();
    __syncthreads();
  }
  int rot = 384;
  for (int j = 0; j < 2; ++j) {
    u16* wm = W + OFF_WMLA + j * SZ_MLA;
    tr_job(p.mla_w_dq + (size_t)j * 1024 * 384, 1024, 384, wm, nullptr, 1.f, rot, vb, G, tile);
    tr_job(p.mla_w_dkv + (size_t)j * 1024 * 320, 1024, 320, wm + 384 * 1024, nullptr, 1.f, rot, vb, G, tile);
    tr_job(p.mla_w_uq + (size_t)j * 384 * 1536, 384, 1536, wm + SZ_MLA_W1, p.mla_g_q + j * 384, 1.f, rot, vb, G, tile);
    tr_job(p.mla_w_ukv + (size_t)j * 256 * 2048, 256, 2048, wm + SZ_MLA_W1 + SZ_MLA_UQ, p.mla_g_kv + j * 256, 1.f, rot, vb, G, tile);
    tr_job(p.mla_w_o + (size_t)j * 1024 * 1024, 1024, 1024, wm + SZ_MLA_W1 + SZ_MLA_UQ + SZ_MLA_UKV, nullptr, 1.f, rot, vb, G, tile);
    u16* wg = W + OFF_WGLA + j * SZ_GLA;
    tr_job(p.gla_w_q + (size_t)j * 1024 * 512, 1024, 512, wg, nullptr, 0.08838834764831845f, rot, vb, G, tile);
    tr_job(p.gla_w_k + (size_t)j * 1024 * 512, 1024, 512, wg + 512 * 1024, nullptr, 1.f, rot, vb, G, tile);
    tr_job(p.gla_w_v + (size_t)j * 1024 * 1024, 1024, 1024, wg + 1024 * 1024, nullptr, 1.f, rot, vb, G, tile);
    tr_job(p.gla_w_r + (size_t)j * 1024 * 1024, 1024, 1024, wg + 2048 * 1024, nullptr, 1.f, rot, vb, G, tile);
    tr_job(p.gla_w_o + (size_t)j * 1024 * 1024, 1024, 1024, wg + SZ_GLA_W1, nullptr, 1.f, rot, vb, G, tile);
    for (int idx = vb * NTHR + tid; idx < 32768; idx += G * NTHR) {
      int dir = idx >> 14, r = (idx >> 10) & 15, k = idx & 1023;
      wg[(size_t)(3072 + dir * 16 + r) * 1024 + k] = f2bf(p.gla_w_gate1[(((size_t)j * 2 + dir) * 1024 + k) * 16 + r]);
    }
    for (int idx = vb * NTHR + tid; idx < 96 * 1024; idx += G * NTHR) wg[(size_t)3104 * 1024 + idx] = 0;
    for (int idx = vb * NTHR + tid; idx < 64 * 1024; idx += G * NTHR) wm[(size_t)704 * 1024 + idx] = 0;
    VM_DRAIN();
  }
  for (int i = 0; i < 4; ++i) {
    u16* wp = W + OFF_WMLP + i * SZ_MLP;
    tr_job(p.mlp_w1 + (size_t)i * 1024 * 4096, 1024, 4096, wp, nullptr, 1.f, rot, vb, G, tile);
    tr_job(p.mlp_w2 + (size_t)i * 4096 * 1024, 4096, 1024, wp + SZ_MLP1, nullptr, 1.f, rot, vb, G, tile);
  }
}

DEV void row_pass(const Params& p, int layer_add, int gate_idx, int gadd_idx,
                  int layer_norm, int sh_idx, int sc_idx, int gnorm_idx, bool first, bool last) {
  const int tid_ = tidx(); const int lane = tid_ & 63;
  const int gw = blockIdx.x * 8 + (tid_ >> 6), nw = gridDim.x * 8;
  const float* mod = reinterpret_cast<const float*>(p.ws + WS_MOD);
  float* xctx = reinterpret_cast<float*>(p.ws + WS_XCTX);
  u16* hbuf = reinterpret_cast<u16*>(p.ws + WS_H);
  const u16* ybuf = reinterpret_cast<const u16*>(p.ws + WS_Y);
  for (int m = gw; m < MROWS; m += nw) {
    int b = m / TT, t = m - b * TT;
    bool isctx = t < CTX;
    int w = isctx ? 4 : b;
    if (last && isctx) continue;
    float* xp = isctx ? xctx + (size_t)(b * CTX + t) * DM : p.out + ((size_t)b * SEQ + (t - CTX)) * DM;
    const float* xin = first ? (isctx ? p.ctx + (size_t)(b * CTX + t) * DM : p.x + ((size_t)b * SEQ + (t - CTX)) * DM) : xp;
    float4 xv[4];
#pragma unroll
    for (int q = 0; q < 4; ++q) xv[q] = *reinterpret_cast<const float4*>(xin + q * 256 + lane * 4);
    if (layer_add >= 0) {
      const float* gate = mod + (size_t)((layer_add * 5 + w) * 6 + gate_idx) * 1024;
      const float* g = p.norm_g + (size_t)(layer_add * 4 + gadd_idx) * 1024;
      u32x2 yy[4]; float ys = 0;
#pragma unroll
      for (int q = 0; q < 4; ++q) {
        yy[q] = *reinterpret_cast<const u32x2*>(ybuf + (size_t)m * 1024 + q * 256 + lane * 4);
        float y0 = bflo(yy[q][0]), y1 = bfhi(yy[q][0]), y2 = bflo(yy[q][1]), y3 = bfhi(yy[q][1]);
        ys += y0 * y0 + y1 * y1 + y2 * y2 + y3 * y3;
      }
      ys = wave_sum(ys);
      const float r = rsqrtf(ys * (1.f / 1024.f) + EPS);
#pragma unroll
      for (int q = 0; q < 4; ++q) {
        int col = q * 256 + lane * 4;
        float4 gt = *reinterpret_cast<const float4*>(gate + col);
        float4 gg = *reinterpret_cast<const float4*>(g + col);
        xv[q].x += gt.x * (gg.x * (bflo(yy[q][0]) * r)); xv[q].y += gt.y * (gg.y * (bfhi(yy[q][0]) * r));
        xv[q].z += gt.z * (gg.z * (bflo(yy[q][1]) * r)); xv[q].w += gt.w * (gg.w * (bfhi(yy[q][1]) * r));
      }
    }
    if (layer_add >= 0 || first) {
#pragma unroll
      for (int q = 0; q < 4; ++q) *reinterpret_cast<float4*>(xp + q * 256 + lane * 4) = xv[q];
    }
    if (layer_norm >= 0) {
      float ss = 0;
#pragma unroll
      for (int q = 0; q < 4; ++q) ss += xv[q].x * xv[q].x + xv[q].y * xv[q].y + xv[q].z * xv[q].z + xv[q].w * xv[q].w;
      ss = wave_sum(ss);
      float r0 = rsqrtf(ss * (1.f / 1024.f) + EPS);
      const float* sh = mod + (size_t)((layer_norm * 5 + w) * 6 + sh_idx) * 1024;
      const float* scl = mod + (size_t)((layer_norm * 5 + w) * 6 + sc_idx) * 1024;
      const float* g = p.norm_g + (size_t)(layer_norm * 4 + gnorm_idx) * 1024;
#pragma unroll
      for (int q = 0; q < 4; ++q) {
        int col = q * 256 + lane * 4;
        float4 s4 = *reinterpret_cast<const float4*>(sh + col);
        float4 c4 = *reinterpret_cast<const float4*>(scl + col);
        float4 gg = *reinterpret_cast<const float4*>(g + col);
        float h0 = (xv[q].x * r0 * gg.x) * (1.f + c4.x) + s4.x, h1 = (xv[q].y * r0 * gg.y) * (1.f + c4.y) + s4.y;
        float h2 = (xv[q].z * r0 * gg.z) * (1.f + c4.z) + s4.z, h3 = (xv[q].w * r0 * gg.w) * (1.f + c4.w) + s4.w;
        u32x2 pk = {cvtpk(h0, h1), cvtpk(h2, h3)};
        *reinterpret_cast<u32x2*>(hbuf + (size_t)m * 1024 + col) = pk;
      }
    }
    VM_DRAIN();
  }
}

DEV u32x4 widen16(u32x2 x, u32x2 y) {
  auto r0 = __builtin_amdgcn_permlane16_swap(x[0], y[0], false, false);
  auto r1 = __builtin_amdgcn_permlane16_swap(x[1], y[1], false, false);
  return u32x4{r0[0], r1[0], r0[1], r1[1]};
}
struct Epi { u16* o0; u16* o1; u16* o2; float* f0; float* s0; float* s1; const float* r0; };
enum { E_Y = 0, E_MLP1 = 1, E_MLA1 = 2, E_MLAQ = 3, E_MLAKV = 4, E_GLA1 = 5 };

template <int EPI, int MT = 4>
DEV void gemm_phase(const u16* __restrict__ A, int lda, const u16* __restrict__ Bt, int K, int N, int rot, int vb, int G, char* lds, const Epi& e) {
  int tid = threadIdx.x; asm volatile("" : "+v"(tid)); const int lane = tid & 63, w = tid >> 6, wm = w >> 1, wn = w & 1, l15 = lane & 15, lq = lane >> 4;
  const int ntn = N >> 7, total = (MROWS / (64 * MT)) * ntn, nk = K >> 6;
  char* As = lds; char* Bs = lds + 98304;
  const int srow = tid >> 3, sch = tid & 7;
  if (__builtin_amdgcn_readfirstlane(w) >= 4) __builtin_amdgcn_s_setprio(1);
  int start = (vb - (rot % G) + G) % G;
  for (int t = start; t < total; t += G) {
    int mb = t / ntn, nb = t - mb * ntn;
    if (MT == 4 && ntn > 8 && (ntn & 7) == 0) {
      const int sidx = t >> 5, j5 = t & 31, scols = ntn >> 3, smb = sidx / scols, snb = sidx - smb * scols;
      mb = smb * 4 + (j5 >> 3); nb = snb * 8 + (j5 & 7);
    }
    const int m0 = mb * (64 * MT), n0 = nb * 128;
    f32x4 acc[4][MT];
    float zf_ = 0.f; asm volatile("" : "+v"(zf_));
#pragma unroll
    for (int i = 0; i < 4; ++i)
#pragma unroll
      for (int j = 0; j < MT; ++j) acc[i][j] = f32x4{zf_, zf_, zf_, zf_};
    auto stage = [&](int kt, int buf) {
#pragma unroll
      for (int i = 0; i < MT; ++i) { const int row = srow + i * 64;
        const u16* g = A + (size_t)(m0 + row) * lda + kt * 64 + ((sch ^ ((row >> 1) & 7)) << 3);
        __builtin_amdgcn_global_load_lds((const unsigned*)g, (unsigned*)(As + buf * 32768 + row * 128 + sch * 16), 16, 0, 0); }
#pragma unroll
      for (int i = 0; i < 2; ++i) { const int row = srow + i * 64;
        const u16* g = Bt + (size_t)(n0 + row) * K + kt * 64 + ((sch ^ ((row >> 1) & 7)) << 3);
        __builtin_amdgcn_global_load_lds((const unsigned*)g, (unsigned*)(Bs + buf * 16384 + row * 128 + sch * 16), 16, 0, 0); }
    };
    __syncthreads();
    if constexpr (EPI == E_MLAQ || EPI == E_MLAKV) {
      const int rrow = tid >> 1, hh = tid & 1, kh = K >> 1;
      const u16* ap = A + (size_t)(m0 + rrow) * lda + hh * kh;
      float ss = 0;
      for (int c = 0; c < kh; c += 8) {
        u32x4 v = *reinterpret_cast<const u32x4*>(ap + c);
#pragma unroll
        for (int z = 0; z < 4; ++z) { float lo = bflo(v[z]), hi2 = bfhi(v[z]); ss += lo * lo + hi2 * hi2; }
      }
      ss += __shfl_xor(ss, 1);
      if (hh == 0) reinterpret_cast<float*>(lds + 147456)[rrow] = rsqrtf(ss / (float)K + EPS);
    }
    asm volatile("s_waitcnt vmcnt(0) lgkmcnt(0)" ::: "memory");
    __syncthreads();
    stage(0, 0); stage(1, 1);
    int cb = 0, pb = 2;
    for (int kt = 0; kt < nk; ++kt) {
      if (kt + 1 < nk) asm volatile("s_waitcnt vmcnt(%0)" :: "n"(MT + 2) : "memory"); else asm volatile("s_waitcnt vmcnt(0)" ::: "memory");
      __builtin_amdgcn_s_barrier();
      __builtin_amdgcn_sched_barrier(0);
      const char* Ac = As + cb * 32768; const char* Bc = Bs + cb * 16384;
      bf16x8 bw[2][4], at[2][MT];
#pragma unroll
      for (int kk = 0; kk < 2; ++kk) {
        const int ch = kk * 4 + lq;
#pragma unroll
        for (int nt = 0; nt < 4; ++nt) bw[kk][nt] = *reinterpret_cast<const bf16x8*>(Bc + off128(wn * 64 + nt * 16 + l15, ch));
#pragma unroll
        for (int mt = 0; mt < MT; ++mt) at[kk][mt] = *reinterpret_cast<const bf16x8*>(Ac + off128(wm * (16 * MT) + mt * 16 + l15, ch));
      }
      __builtin_amdgcn_sched_barrier(0);
      if (kt + 2 < nk) stage(kt + 2, pb);
      __builtin_amdgcn_sched_barrier(0);
#pragma unroll
      for (int kk = 0; kk < 2; ++kk)
#pragma unroll
        for (int nt = 0; nt < 4; ++nt)
#pragma unroll
          for (int mt = 0; mt < MT; ++mt) acc[nt][mt] = mfma16(bw[kk][nt], at[kk][mt], acc[nt][mt]);
      cb = (cb == 2) ? 0 : cb + 1; pb = (pb == 2) ? 0 : pb + 1;
    }
    asm volatile("s_waitcnt lgkmcnt(0)" ::: "memory");
    __syncthreads();
    const int nw = n0 + wn * 64;
    const int mbase = m0 + wm * (16 * MT) + l15;
    const int nl = lq * 4;
    if constexpr (EPI == E_Y) {
#pragma unroll
      for (int mt = 0; mt < MT; ++mt) {
        const int m = mbase + mt * 16;
#pragma unroll
        for (int nt = 0; nt < 4; nt += 2) {
          f32x4 v = acc[nt][mt], v2 = acc[nt + 1][mt];
          u32x4 wv = widen16(u32x2{cvtpk(v[0], v[1]), cvtpk(v[2], v[3])}, u32x2{cvtpk(v2[0], v2[1]), cvtpk(v2[2], v2[3])});
          *reinterpret_cast<u32x4*>(e.o0 + (size_t)m * 1024 + nw + (nt + (lq & 1)) * 16 + (lq & 2) * 4) = wv;
        }
      }
    } else if constexpr (EPI == E_MLP1) {
#pragma unroll
      for (int mt = 0; mt < MT; ++mt) {
        const int m = mbase + mt * 16;
#pragma unroll
        for (int nt = 0; nt < 4; nt += 2) {
          f32x4 v = acc[nt][mt], v2 = acc[nt + 1][mt];
#pragma unroll
          for (int j = 0; j < 4; ++j) { float r = fmaxf(v[j], 0.f); v[j] = r * r; float r2 = fmaxf(v2[j], 0.f); v2[j] = r2 * r2; }
          u32x4 wv = widen16(u32x2{cvtpk(v[0], v[1]), cvtpk(v[2], v[3])}, u32x2{cvtpk(v2[0], v2[1]), cvtpk(v2[2], v2[3])});
          __builtin_nontemporal_store(wv, reinterpret_cast<u32x4*>(e.o0 + (size_t)m * 4096 + nw + (nt + (lq & 1)) * 16 + (lq & 2) * 4));
        }
      }
    } else if constexpr (EPI == E_MLA1) {
      if (nw < 640) {
        const bool isq = nw < 384;
#pragma unroll
        for (int mt = 0; mt < MT; ++mt) {
          const int m = mbase + mt * 16;
#pragma unroll
          for (int nt = 0; nt < 4; nt += 2) {
            f32x4 v = acc[nt][mt], v2 = acc[nt + 1][mt];
            u32x4 wv = widen16(u32x2{cvtpk(v[0], v[1]), cvtpk(v[2], v[3])}, u32x2{cvtpk(v2[0], v2[1]), cvtpk(v2[2], v2[3])});
            if (isq) *reinterpret_cast<u32x4*>(e.o0 + (size_t)m * 384 + nw + (nt + (lq & 1)) * 16 + (lq & 2) * 4) = wv;
            else     *reinterpret_cast<u32x4*>(e.o1 + (size_t)m * 256 + (nw - 384) + (nt + (lq & 1)) * 16 + (lq & 2) * 4) = wv;
          }
        }
      } else if (nw == 640) {
#pragma unroll
        for (int mt = 0; mt < MT; ++mt) {
          const int m = mbase + mt * 16; const int tt = m % TT;
          if (tt >= CTX) {
            const int pos = tt - CTX; const float pr = (float)(pos >> 6), pc = (float)(pos & 63);
#pragma unroll
            for (int j = 0; j < 4; ++j) {
              rope_rot(acc[0][mt][j], acc[1][mt][j], pr, nl + j);
              rope_rot(acc[2][mt][j], acc[3][mt][j], pc, nl + j);
            }
          }
#pragma unroll
          for (int nt = 0; nt < 4; nt += 2) {
            f32x4 v = acc[nt][mt], v2 = acc[nt + 1][mt];
            u32x4 wv = widen16(u32x2{cvtpk(v[0], v[1]), cvtpk(v[2], v[3])}, u32x2{cvtpk(v2[0], v2[1]), cvtpk(v2[2], v2[3])});
            *reinterpret_cast<u32x4*>(e.o2 + (size_t)m * 64 + (nt + (lq & 1)) * 16 + (lq & 2) * 4) = wv;
          }
        }
      }
    } else if constexpr (EPI == E_MLAQ) {
      const bool ropet = (nw % 192) == 128;
#pragma unroll
      for (int mt = 0; mt < MT; ++mt) {
        const int m = mbase + mt * 16; const int tt = m % TT;
        const float rs = reinterpret_cast<const float*>(lds + 147456)[wm * 64 + mt * 16 + l15];
#pragma unroll
        for (int nt = 0; nt < 4; ++nt) acc[nt][mt] = acc[nt][mt] * rs;
        if (ropet && tt >= CTX) {
          const int pos = tt - CTX; const float pr = (float)(pos >> 6), pc = (float)(pos & 63);
#pragma unroll
          for (int j = 0; j < 4; ++j) {
            rope_rot(acc[0][mt][j], acc[1][mt][j], pr, nl + j);
            rope_rot(acc[2][mt][j], acc[3][mt][j], pc, nl + j);
          }
        }
#pragma unroll
        for (int nt = 0; nt < 4; nt += 2) {
          f32x4 v = acc[nt][mt], v2 = acc[nt + 1][mt];
          u32x4 wv = widen16(u32x2{cvtpk(v[0], v[1]), cvtpk(v[2], v[3])}, u32x2{cvtpk(v2[0], v2[1]), cvtpk(v2[2], v2[3])});
          *reinterpret_cast<u32x4*>(e.o0 + (size_t)m * 1536 + nw + (nt + (lq & 1)) * 16 + (lq & 2) * 4) = wv;
        }
      }
    } else if constexpr (EPI == E_MLAKV) {
#pragma unroll
      for (int mt = 0; mt < MT; ++mt) {
        const int m = mbase + mt * 16;
        const float rs = reinterpret_cast<const float*>(lds + 147456)[wm * 64 + mt * 16 + l15];
#pragma unroll
        for (int nt = 0; nt < 4; nt += 2) {
          f32x4 v = acc[nt][mt] * rs, v2 = acc[nt + 1][mt] * rs;
          u32x4 wv = widen16(u32x2{cvtpk(v[0], v[1]), cvtpk(v[2], v[3])}, u32x2{cvtpk(v2[0], v2[1]), cvtpk(v2[2], v2[3])});
          *reinterpret_cast<u32x4*>(e.o0 + (size_t)m * 2048 + nw + (nt + (lq & 1)) * 16 + (lq & 2) * 4) = wv;
        }
      }
    } else if constexpr (EPI == E_GLA1) {
      if (nw < 3072) {
        u16* dst = e.o0 + (size_t)(nw >> 10) * ((size_t)MROWS * 1024);
        const int nc = nw & 1023; const bool dosilu = nw >= 2048;
#pragma unroll
        for (int mt = 0; mt < MT; ++mt) {
          const int m = mbase + mt * 16;
#pragma unroll
          for (int nt = 0; nt < 4; nt += 2) {
            f32x4 v = acc[nt][mt], v2 = acc[nt + 1][mt];
            if (dosilu) {
#pragma unroll
              for (int j = 0; j < 4; ++j) { v[j] = silu_f(v[j]); v2[j] = silu_f(v2[j]); }
            }
            u32x4 wv = widen16(u32x2{cvtpk(v[0], v[1]), cvtpk(v[2], v[3])}, u32x2{cvtpk(v2[0], v2[1]), cvtpk(v2[2], v2[3])});
            *reinterpret_cast<u32x4*>(dst + (size_t)m * 1024 + nc + (nt + (lq & 1)) * 16 + (lq & 2) * 4) = wv;
          }
        }
      } else if (nw == 3072) {
#pragma unroll
        for (int mt = 0; mt < MT; ++mt) {
          const int m = mbase + mt * 16;
#pragma unroll
          for (int nt = 0; nt < 2; ++nt) *reinterpret_cast<f32x4*>(e.f0 + (size_t)m * 32 + nt * 16 + nl) = acc[nt][mt];
        }
      }
    }
    VM_DRAIN();
  }
  __builtin_amdgcn_s_setprio(0);
}

constexpr int KVBLK = 64;
constexpr float ATT_SCALE = 0.07216878364870322f;
constexpr float ATT_THR = 8.f;
constexpr int SHM_K = KVBLK * 192 * 2, SHM_V = KVBLK * 128 * 2;
#define KSWZ(row, colB) ((row) * 384 + ((colB) ^ ((((row) >> 1) & 7) << 4)))
#define SBAR() __builtin_amdgcn_sched_barrier(0)
DEV int crow(int r, int hi) { return (r & 3) + 8 * (r >> 2) + 4 * hi; }

DEV void partialSM(f32x16& p0, f32x16& p1, float& m_reg, float& mn, float& alpha) {
  constexpr float C = ATT_SCALE * 1.4426950408889634f;
  float pmax = p0[0];
#pragma unroll
  for (int r = 1; r < 16; ++r) pmax = fmaxf(pmax, p0[r]);
#pragma unroll
  for (int r = 0; r < 16; ++r) pmax = fmaxf(pmax, p1[r]);
  { auto rr = __builtin_amdgcn_permlane32_swap(__float_as_uint(pmax), __float_as_uint(pmax), false, false);
    pmax = fmaxf(__uint_as_float(rr[0]), __uint_as_float(rr[1])); }
  if (__builtin_expect(__all(pmax - m_reg <= ATT_THR / ATT_SCALE), 1)) { mn = m_reg; alpha = 1.f; }
  else { mn = fmaxf(m_reg, pmax); alpha = __builtin_amdgcn_exp2f((m_reg - mn) * C); m_reg = mn; }
  float mnC = -mn * C;
#pragma unroll
  for (int r = 0; r < 16; ++r) p0[r] = fmaf(p0[r], C, mnC);
#pragma unroll
  for (int r = 0; r < 16; ++r) p1[r] = fmaf(p1[r], C, mnC);
#pragma unroll
  for (int r = 0; r < 16; ++r) p0[r] = __builtin_amdgcn_exp2f(p0[r]);
}
DEV void finishSM(f32x16& p0, f32x16& p1, float alpha, float& l_reg, bf16x8& pa0, bf16x8& pa1, bf16x8& pa2, bf16x8& pa3) {
#pragma unroll
  for (int r = 0; r < 16; ++r) p1[r] = __builtin_amdgcn_exp2f(p1[r]);
  float ps = 0;
#pragma unroll
  for (int r = 0; r < 16; ++r) ps += p0[r];
#pragma unroll
  for (int r = 0; r < 16; ++r) ps += p1[r];
  { auto rr = __builtin_amdgcn_permlane32_swap(__float_as_uint(ps), __float_as_uint(ps), false, false);
    ps = __uint_as_float(rr[0]) + __uint_as_float(rr[1]); }
  l_reg = l_reg * alpha + ps;
#define PK4(P, BASE, OUT) do { unsigned a0 = cvtpk(P[BASE + 0], P[BASE + 1]), a1 = cvtpk(P[BASE + 2], P[BASE + 3]);   \
    unsigned b0 = cvtpk(P[BASE + 4], P[BASE + 5]), b1 = cvtpk(P[BASE + 6], P[BASE + 7]);                              \
    auto r0 = __builtin_amdgcn_permlane32_swap(a0, b0, false, false); auto r1 = __builtin_amdgcn_permlane32_swap(a1, b1, false, false); \
    u32x4 w = {r0[0], r1[0], r0[1], r1[1]}; OUT = *reinterpret_cast<bf16x8*>(&w); } while (0)
  PK4(p0, 0, pa0); PK4(p0, 8, pa1); PK4(p1, 0, pa2); PK4(p1, 8, pa3);
#undef PK4
}
DEV void qkt(f32x16& p0, f32x16& p1, const char* Ks, const bf16x8* qr, int r32, int hi) {
  { float zf = 0.f; asm volatile("" : "+v"(zf));
#pragma unroll
    for (int r = 0; r < 16; ++r) { p0[r] = zf; p1[r] = zf; } }
#pragma unroll
  for (int d0 = 0; d0 < 12; ++d0) { int cb = (d0 * 16 + hi * 8) * 2;
    bf16x8 b0 = *reinterpret_cast<const bf16x8*>(Ks + KSWZ(r32, cb));
    bf16x8 b1 = *reinterpret_cast<const bf16x8*>(Ks + KSWZ(32 + r32, cb));
    p0 = __builtin_amdgcn_mfma_f32_32x32x16_bf16(b0, qr[d0], p0, 0, 0, 0);
    p1 = __builtin_amdgcn_mfma_f32_32x32x16_bf16(b1, qr[d0], p1, 0, 0, 0); }
}
DEV int v_st(int k, int c) { const int kk = (k & ~0xC) | ((k & 4) << 1) | ((k & 8) >> 1); return ((kk >> 3) * 4 + (c >> 5)) * 512 + ((kk & 7) * 32 + (c & 31)) * 2; }
DEV int v_rd_base(int lane) { return ((lane & 3) << 3) | (((lane >> 2) & 3) << 6) | (((lane >> 4) & 1) << 5) | (((lane >> 5) & 1) << 8); }
constexpr int v_rd_off(int d0, int ks, int half) { return d0 * 512 + ks * 4096 + half * 2048; }
template <int OFF> DEV s16x4 tr_read(int vb) {
  s16x4 r; asm volatile("ds_read_b64_tr_b16 %0, %1 offset:%2" : "=&v"(r) : "v"(vb), "i"(OFF) : "memory"); return r;
}
template <int D0> DEV void pv_one(f32x16& od, int vb, bf16x8 pa0, bf16x8 pa1, bf16x8 pa2, bf16x8 pa3) {
  s16x4 l0, h0, l1, h1, l2, h2, l3, h3;
  asm volatile("ds_read_b64_tr_b16 %0, %8 offset:%9\n\t"
               "ds_read_b64_tr_b16 %1, %8 offset:%10\n\t"
               "ds_read_b64_tr_b16 %2, %8 offset:%11\n\t"
               "ds_read_b64_tr_b16 %3, %8 offset:%12\n\t"
               "ds_read_b64_tr_b16 %4, %8 offset:%13\n\t"
               "ds_read_b64_tr_b16 %5, %8 offset:%14\n\t"
               "ds_read_b64_tr_b16 %6, %8 offset:%15\n\t"
               "ds_read_b64_tr_b16 %7, %8 offset:%16\n\t"
               "s_waitcnt lgkmcnt(0)"
               : "=&v"(l0), "=&v"(h0), "=&v"(l1), "=&v"(h1), "=&v"(l2), "=&v"(h2), "=&v"(l3), "=&v"(h3)
               : "v"(vb), "i"(v_rd_off(D0, 0, 0)), "i"(v_rd_off(D0, 0, 1)), "i"(v_rd_off(D0, 1, 0)), "i"(v_rd_off(D0, 1, 1)),
                 "i"(v_rd_off(D0, 2, 0)), "i"(v_rd_off(D0, 2, 1)), "i"(v_rd_off(D0, 3, 0)), "i"(v_rd_off(D0, 3, 1))
               : "memory");
  SBAR();
#define PKV(L, H) (bf16x8){L[0], L[1], L[2], L[3], H[0], H[1], H[2], H[3]}
  od = __builtin_amdgcn_mfma_f32_32x32x16_bf16(pa0, PKV(l0, h0), od, 0, 0, 0);
  od = __builtin_amdgcn_mfma_f32_32x32x16_bf16(pa1, PKV(l1, h1), od, 0, 0, 0);
  od = __builtin_amdgcn_mfma_f32_32x32x16_bf16(pa2, PKV(l2, h2), od, 0, 0, 0);
  od = __builtin_amdgcn_mfma_f32_32x32x16_bf16(pa3, PKV(l3, h3), od, 0, 0, 0);
#undef PKV
}
DEV void pv_d0(f32x16* o, int vb, bf16x8 pa0, bf16x8 pa1, bf16x8 pa2, bf16x8 pa3) {
  pv_one<0>(o[0], vb, pa0, pa1, pa2, pa3); pv_one<1>(o[1], vb, pa0, pa1, pa2, pa3); pv_one<2>(o[2], vb, pa0, pa1, pa2, pa3); pv_one<3>(o[3], vb, pa0, pa1, pa2, pa3);
}

DEV void attn_body(const u16* __restrict__ Qb, const u16* __restrict__ Kn, const u16* __restrict__ Kr, const u16* __restrict__ Vh,
                   u16* __restrict__ Ob, int seq, char* lds) {
  int tid = threadIdx.x; asm volatile("" : "+v"(tid)); const int wid = tid >> 6, lane = tid & 63, r32 = lane & 31, hi = lane >> 5;
  char* V_lds = lds; char* K_lds = lds + 2 * SHM_V;
  float* wsl = reinterpret_cast<float*>(lds + 2 * SHM_V + 2 * SHM_K) + wid * 64; float* li_l = wsl; float* al_l = wsl + 32;
  asm volatile("s_waitcnt vmcnt(0) lgkmcnt(0)" ::: "memory");
  __syncthreads();
  float m_reg = -1e30f, l_reg = 0; f32x16 o[4] = {}; bf16x8 qr[12];
  const u16* Qw = Qb + (size_t)(wid * 32 + r32) * 1536 + hi * 8;
#pragma unroll
  for (int d0 = 0; d0 < 12; ++d0) qr[d0] = *reinterpret_cast<const bf16x8*>(Qw + d0 * 16);
  const int sr = tid >> 4, sc = (tid & 15) * 8, vst0 = v_st(sr, sc), vst1 = v_st(32 + sr, sc);
  const int rr_ = tid >> 3, rc_ = (tid & 7) * 8;
  const int vb0 = (int)(uintptr_t)V_lds + v_rd_base(lane);
  bf16x8 vs0, vs1, ks0, ks1, kr0;
#define SLOAD(k0) do { vs0 = *reinterpret_cast<const bf16x8*>(Vh + (size_t)((k0) + sr) * 2048 + sc); vs1 = *reinterpret_cast<const bf16x8*>(Vh + (size_t)((k0) + 32 + sr) * 2048 + sc); \
    ks0 = *reinterpret_cast<const bf16x8*>(Kn + (size_t)((k0) + sr) * 2048 + sc); ks1 = *reinterpret_cast<const bf16x8*>(Kn + (size_t)((k0) + 32 + sr) * 2048 + sc); \
    kr0 = *reinterpret_cast<const bf16x8*>(Kr + (size_t)((k0) + rr_) * 64 + rc_); } while (0)
#define SWRITE(b) do { *reinterpret_cast<bf16x8*>(V_lds + (b) * SHM_V + vst0) = vs0; *reinterpret_cast<bf16x8*>(V_lds + (b) * SHM_V + vst1) = vs1; \
    *reinterpret_cast<bf16x8*>(K_lds + (b) * SHM_K + KSWZ(sr, sc * 2)) = ks0; *reinterpret_cast<bf16x8*>(K_lds + (b) * SHM_K + KSWZ(32 + sr, sc * 2)) = ks1; \
    *reinterpret_cast<bf16x8*>(K_lds + (b) * SHM_K + KSWZ(rr_, 256 + rc_ * 2)) = kr0; } while (0)
#define SWAIT() asm volatile("s_waitcnt vmcnt(0)" ::: "memory")
#define RESC(a) do { if (__any((a) < 1.f)) { if (hi == 0) al_l[r32] = (a); asm volatile("s_waitcnt lgkmcnt(0)" ::: "memory"); \
    _Pragma("unroll") for (int d = 0; d < 4; ++d) _Pragma("unroll") for (int r = 0; r < 16; ++r) o[d][r] *= al_l[crow(r, hi)]; } } while (0)
  f32x16 pA0, pA1; float mnA, alA; bf16x8 pa0, pa1, pa2, pa3; const int NTL = seq / KVBLK;
  SLOAD(0); SWAIT(); SWRITE(0); __syncthreads();
  for (int j = 0; j < NTL; ++j) {
    const int cur = j & 1;
    if (j + 1 < NTL) SLOAD((j + 1) * KVBLK);
    SBAR(); qkt(pA0, pA1, K_lds + cur * SHM_K, qr, r32, hi);
    partialSM(pA0, pA1, m_reg, mnA, alA);
    RESC(alA);
    finishSM(pA0, pA1, alA, l_reg, pa0, pa1, pa2, pa3); SBAR();
    pv_d0(o, vb0 + cur * SHM_V, pa0, pa1, pa2, pa3);
    if (j + 1 < NTL) { SWAIT(); SWRITE(cur ^ 1); }
    __syncthreads();
  }
  if (hi == 0) li_l[r32] = l_reg; asm volatile("s_waitcnt lgkmcnt(0)" ::: "memory");
  u16* Ow = Ob + (size_t)(wid * 32) * 1024;
  unsigned voff = hi * 4096 + r32;
  asm volatile("" : "+v"(voff));
#pragma unroll
  for (int r = 0; r < 16; ++r) { const int cr = (r & 3) + 8 * (r >> 2); float rl = __builtin_amdgcn_rcpf(li_l[cr + 4 * hi]);
    u16* rowp = Ow + cr * 1024;
#pragma unroll
    for (int d0 = 0; d0 < 4; ++d0) rowp[voff + d0 * 32] = f2bf(o[d0][r] * rl); }
  asm volatile("s_waitcnt vmcnt(0) lgkmcnt(0)" ::: "memory");
  __syncthreads();
#undef SLOAD
#undef SWRITE
#undef SWAIT
#undef RESC
}

DEV void attn_phase(const Params& p, bool need_ctx, int vb, int G, char* lds) {
  const u16* q = reinterpret_cast<const u16*>(p.ws + WS_R);
  const u16* kv = q + (size_t)MROWS * 1536;
  const u16* krope = reinterpret_cast<const u16*>(p.ws + WS_Y) + (size_t)MROWS * (384 + 256);
  u16* ob = reinterpret_cast<u16*>(p.ws + WS_H);
  const int nitems = 1024 + (need_ctx ? 32 : 0);
  if (__builtin_amdgcn_readfirstlane((int)(threadIdx.x >> 6)) >= 4) __builtin_amdgcn_s_setprio(1);
  for (int it = vb; it < nitems; it += G) {
    int bh, qrow0, seq;
    if (it < 1024) { bh = it >> 5; qrow0 = CTX + (it & 31) * 256; seq = TT; }
    else { bh = it - 1024; qrow0 = 0; seq = CTX; }
    const int b = bh >> 3, h = bh & 7;
    const size_t r0 = (size_t)b * TT;
    attn_body(q + (r0 + qrow0) * 1536 + h * 192, kv + r0 * 2048 + h * 256, krope + r0 * 64, kv + r0 * 2048 + h * 256 + 128,
              ob + (r0 + qrow0) * 1024 + h * 128, seq, lds);
  }
  __builtin_amdgcn_s_setprio(0);
}

DEV void gla_scan(const Params& p, int lj, int vb, int G, char* lds) {
  int tid = threadIdx.x; asm volatile("" : "+v"(tid)); const int lane = tid & 63, w = tid >> 6, l15 = lane & 15, lq = lane >> 4;
  const u16* qk = reinterpret_cast<const u16*>(p.ws + WS_R);
  const u16* vbuf = qk + (size_t)MROWS * 1024;
  const float* gl = reinterpret_cast<const float*>(p.ws + WS_R + (size_t)MROWS * 1024 * 2 * 3);
  u16* rawQ = reinterpret_cast<u16*>(lds); u16* rawK = reinterpret_cast<u16*>(lds + 16384); u16* rawV = reinterpret_cast<u16*>(lds + 32768);
  float* glS = reinterpret_cast<float*>(lds + 36864);
  char* qt = lds + 40960; char* kt = lds + 57344; char* kendT = lds + 73728; char* vT = lds + 90112; char* Ab = lds + 94208; char* ST = lds + 102400;
  float* decS = reinterpret_cast<float*>(lds + 110592); float* gsum = reinterpret_cast<float*>(lds + 111104);
  const int d = tid & 127, ig = tid >> 7;
  for (int u = vb; u < 256; u += G) {
    const int s = u & 7, dir = (u >> 3) & 1, h = (u >> 4) & 3, b = u >> 6;
    u16* odir = reinterpret_cast<u16*>(p.ws + (dir == 0 ? WS_H : WS_Y));
    const int dg = w * 16 + l15;
    bf16x8 w2f;
    { float wv_[8];
#pragma unroll
      for (int jj = 0; jj < 8; ++jj) { const int r = (lq & 1) * 8 + jj;
        const float v = p.gla_w_gate2[((size_t)(lj * 2 + dir) * 16 + r) * 512 + h * 128 + dg]; wv_[jj] = (lq < 2) ? v : 0.f; }
      u32x4 wv4 = {cvtpk(wv_[0], wv_[1]), cvtpk(wv_[2], wv_[3]), cvtpk(wv_[4], wv_[5]), cvtpk(wv_[6], wv_[7])};
      w2f = *reinterpret_cast<bf16x8*>(&wv4); }
    const float bias = p.gla_b_gate[(size_t)(lj * 2 + dir) * 512 + h * 128 + dg];
    f32x4 Sacc[2] = {f32x4{0, 0, 0, 0}, f32x4{0, 0, 0, 0}};
    __syncthreads();
    *reinterpret_cast<u32x4*>(ST + tid * 16) = u32x4{0, 0, 0, 0};
    bf16x8 pq[2], pk[2]; u32x4 pv;
    auto rowof = [&](int n, int i) -> size_t { int pp = n * 64 + i; int t = (dir == 0) ? pp : (pp < CTX ? (CTX - 1 - pp) : (TT + CTX - 1 - pp)); return (size_t)b * TT + t; };
    auto gload = [&](int n) {
#pragma unroll
      for (int x = 0; x < 2; ++x) { int c = tid + x * 512, i = c >> 4, ch = c & 15; size_t row = rowof(n, i);
        pq[x] = *reinterpret_cast<const bf16x8*>(qk + row * 1024 + h * 128 + ch * 8);
        pk[x] = *reinterpret_cast<const bf16x8*>(qk + row * 1024 + 512 + h * 128 + ch * 8); }
      if (tid < 256) { int i = tid >> 2, ch = tid & 3; pv = *reinterpret_cast<const u32x4*>(vbuf + rowof(n, i) * 1024 + h * 256 + s * 32 + ch * 8); }
      else { int i = (tid - 256) >> 2, ch = tid & 3; pv = *reinterpret_cast<const u32x4*>(gl + rowof(n, i) * 32 + dir * 16 + ch * 4); }
    };
    auto lstore = [&]() {
#pragma unroll
      for (int x = 0; x < 2; ++x) { int c = tid + x * 512, i = c >> 4, ch = c & 15;
        *reinterpret_cast<bf16x8*>(rawQ + i * 128 + ch * 8) = pq[x]; *reinterpret_cast<bf16x8*>(rawK + i * 128 + ch * 8) = pk[x]; }
      if (tid < 256) { int i = tid >> 2, ch = tid & 3; *reinterpret_cast<u32x4*>(rawV + i * 32 + ch * 8) = pv; }
      else { int i = (tid - 256) >> 2, ch = tid & 3; *reinterpret_cast<u32x4*>(glS + i * 16 + ch * 4) = pv; }
    };
    gload(0); lstore();
    const int it = w >> 1, wv = w & 1;
    for (int n = 0; n < 132; ++n) {
      VM_DRAIN();
      __syncthreads();
      if (n + 1 < 132) gload(n + 1);
      float gq[4][4];
#pragma unroll
      for (int tt = 0; tt < 4; ++tt) {
        const float* gp = glS + (tt * 16 + l15) * 16 + (lq & 1) * 8;
        f32x4 g0 = *reinterpret_cast<const f32x4*>(gp), g1 = *reinterpret_cast<const f32x4*>(gp + 4);
        if (lq >= 2) { g0 = f32x4{0, 0, 0, 0}; g1 = f32x4{0, 0, 0, 0}; }
        u32x4 ga = {cvtpk(g0[0], g0[1]), cvtpk(g0[2], g0[3]), cvtpk(g1[0], g1[1]), cvtpk(g1[2], g1[3])};
        f32x4 xa = mfma16(*reinterpret_cast<bf16x8*>(&ga), w2f, f32x4{0, 0, 0, 0});
#pragma unroll
        for (int j = 0; j < 4; ++j) { const float xg = xa[j] + bias;
          gq[tt][j] = (fminf(xg, 0.f) - __logf(1.f + __expf(-fabsf(xg)))) * (1.f / 16.f); }
      }
      float base = 0.f, tot = 0.f;
#pragma unroll
      for (int tt = 0; tt < 4; ++tt) {
        gq[tt][1] += gq[tt][0]; gq[tt][2] += gq[tt][1]; gq[tt][3] += gq[tt][2];
        const float T = gq[tt][3];
        const float u1 = __shfl(T, (lane - 16) & 63), u2 = __shfl(T, (lane - 32) & 63), u3 = __shfl(T, (lane - 48) & 63);
        const float E = (lq >= 1 ? u1 : 0.f) + (lq >= 2 ? u2 : 0.f) + (lq >= 3 ? u3 : 0.f);
        float S = T + __shfl_xor(T, 16); S += __shfl_xor(S, 32);
#pragma unroll
        for (int j = 0; j < 4; ++j) gq[tt][j] += base + E;
        base += S;
      }
      tot = base;
      if (lq == 0) decS[dg] = __expf(tot);
#pragma unroll
      for (int tt = 0; tt < 4; ++tt) {
        float ke[4];
#pragma unroll
        for (int j = 0; j < 4; ++j) {
          const int i = tt * 16 + lq * 4 + j; const float Gv = gq[tt][j];
          const float qv = bf2f(rawQ[i * 128 + dg]), kvv = bf2f(rawK[i * 128 + dg]);
          *reinterpret_cast<u16*>(qt + off256(i, dg >> 3) + (dg & 7) * 2) = f2bf(qv * __expf(Gv));
          *reinterpret_cast<u16*>(kt + off256(i, dg >> 3) + (dg & 7) * 2) = f2bf(kvv * __expf(-Gv));
          ke[j] = kvv * __expf(tot - Gv);
        }
        *reinterpret_cast<u32x2*>(kendT + off128(dg, tt * 2 + (lq >> 1)) + (lq & 1) * 8) = u32x2{cvtpk(ke[0], ke[1]), cvtpk(ke[2], ke[3])};
      }
      { const int vc = tid & 31, jg = tid >> 5;
        unsigned a0 = rawV[(jg * 4 + 0) * 32 + vc], a1 = rawV[(jg * 4 + 1) * 32 + vc], a2 = rawV[(jg * 4 + 2) * 32 + vc], a3 = rawV[(jg * 4 + 3) * 32 + vc];
        *reinterpret_cast<u32x2*>(vT + off128(vc, jg >> 1) + (jg & 1) * 8) = u32x2{a0 | (a1 << 16), a2 | (a3 << 16)}; }
      __syncthreads();
      if (n + 1 < 132) lstore();
      f32x4 oacc = f32x4{0, 0, 0, 0};
      bf16x8 qa[4];
#pragma unroll
      for (int ks = 0; ks < 4; ++ks) qa[ks] = *reinterpret_cast<const bf16x8*>(qt + off256(it * 16 + l15, ks * 4 + lq));
#pragma unroll
      for (int ks = 0; ks < 4; ++ks) { bf16x8 bb = *reinterpret_cast<const bf16x8*>(ST + off256(wv * 16 + l15, ks * 4 + lq)); oacc = mfma16(qa[ks], bb, oacc); }
#pragma unroll
      for (int x = 0; x < 2; ++x) {
        const int jt = wv * 2 + x; f32x4 aacc = f32x4{0, 0, 0, 0};
        if (jt <= it) {
#pragma unroll
          for (int ks = 0; ks < 4; ++ks) { bf16x8 bb = *reinterpret_cast<const bf16x8*>(kt + off256(jt * 16 + l15, ks * 4 + lq)); aacc = mfma16(qa[ks], bb, aacc); }
        }
#pragma unroll
        for (int jj = 0; jj < 4; ++jj) { const int i = it * 16 + lq * 4 + jj, j = jt * 16 + l15;
          *reinterpret_cast<u16*>(Ab + off128(i, j >> 3) + (j & 7) * 2) = f2bf(j <= i ? aacc[jj] : 0.f); }
      }
      __syncthreads();
#pragma unroll
      for (int ks = 0; ks < 2; ++ks) { bf16x8 a = *reinterpret_cast<const bf16x8*>(Ab + off128(it * 16 + l15, ks * 4 + lq));
        bf16x8 bb = *reinterpret_cast<const bf16x8*>(vT + off128(wv * 16 + l15, ks * 4 + lq)); oacc = mfma16(a, bb, oacc); }
#pragma unroll
      for (int jj = 0; jj < 4; ++jj) { const int i = it * 16 + lq * 4 + jj;
        odir[rowof(n, i) * 1024 + h * 256 + s * 32 + wv * 16 + l15] = f2bf(oacc[jj]); }
      f32x4 dv = *reinterpret_cast<const f32x4*>(decS + w * 16 + lq * 4);
      bf16x8 ka[2];
#pragma unroll
      for (int ks = 0; ks < 2; ++ks) ka[ks] = *reinterpret_cast<const bf16x8*>(kendT + off128(w * 16 + l15, ks * 4 + lq));
#pragma unroll
      for (int vt = 0; vt < 2; ++vt) {
        Sacc[vt] = Sacc[vt] * dv;
#pragma unroll
        for (int ks = 0; ks < 2; ++ks) { bf16x8 bb = *reinterpret_cast<const bf16x8*>(vT + off128(vt * 16 + l15, ks * 4 + lq)); Sacc[vt] = mfma16(ka[ks], bb, Sacc[vt]); }
        *reinterpret_cast<u32x2*>(ST + off256(vt * 16 + l15, w * 2 + (lq >> 1)) + (lq & 1) * 8) = u32x2{cvtpk(Sacc[vt][0], Sacc[vt][1]), cvtpk(Sacc[vt][2], Sacc[vt][3])};
      }
    }
  }
}

DEV void gla_out_pass(const Params& p, int lj) {
  const int tid_ = tidx(); const int lane = tid_ & 63;
  const int gw = blockIdx.x * 8 + (tid_ >> 6), nw = gridDim.x * 8;
  u16* of = reinterpret_cast<u16*>(p.ws + WS_H);
  const u16* ob = reinterpret_cast<const u16*>(p.ws + WS_Y);
  const u16* rb = reinterpret_cast<const u16*>(p.ws + WS_R) + (size_t)MROWS * 2048;
  float go[16];
#pragma unroll
  for (int j = 0; j < 4; ++j) { float4 g4 = *reinterpret_cast<const float4*>(p.gla_g_o + lj * 256 + (lane & 15) * 16 + j * 4); go[j * 4] = g4.x; go[j * 4 + 1] = g4.y; go[j * 4 + 2] = g4.z; go[j * 4 + 3] = g4.w; }
  for (int m = gw; m < MROWS; m += nw) {
    const size_t base = (size_t)m * 1024 + lane * 16;
    u32x4 f0 = *reinterpret_cast<const u32x4*>(of + base), f1 = *reinterpret_cast<const u32x4*>(of + base + 8);
    u32x4 b0 = *reinterpret_cast<const u32x4*>(ob + base), b1 = *reinterpret_cast<const u32x4*>(ob + base + 8);
    u32x4 r0 = *reinterpret_cast<const u32x4*>(rb + base), r1 = *reinterpret_cast<const u32x4*>(rb + base + 8);
    float o[16], rr[16];
#pragma unroll
    for (int j = 0; j < 4; ++j) {
      o[2 * j] = bflo(f0[j]) + bflo(b0[j]); o[2 * j + 1] = bfhi(f0[j]) + bfhi(b0[j]);
      o[8 + 2 * j] = bflo(f1[j]) + bflo(b1[j]); o[8 + 2 * j + 1] = bfhi(f1[j]) + bfhi(b1[j]);
      rr[2 * j] = bflo(r0[j]); rr[2 * j + 1] = bfhi(r0[j]); rr[8 + 2 * j] = bflo(r1[j]); rr[8 + 2 * j + 1] = bfhi(r1[j]);
    }
    float ss = 0;
#pragma unroll
    for (int j = 0; j < 16; ++j) ss += o[j] * o[j];
    ss += __shfl_xor(ss, 8); ss += __shfl_xor(ss, 4); ss += __shfl_xor(ss, 2); ss += __shfl_xor(ss, 1);
    const float rs = rsqrtf(ss * (1.f / 256.f) + EPS);
    float y[16];
#pragma unroll
    for (int j = 0; j < 16; ++j) y[j] = (o[j] * rs * go[j]) * rr[j];
    u32x4 w0 = {cvtpk(y[0], y[1]), cvtpk(y[2], y[3]), cvtpk(y[4], y[5]), cvtpk(y[6], y[7])};
    u32x4 w1 = {cvtpk(y[8], y[9]), cvtpk(y[10], y[11]), cvtpk(y[12], y[13]), cvtpk(y[14], y[15])};
    *reinterpret_cast<u32x4*>(of + base) = w0; *reinterpret_cast<u32x4*>(of + base + 8) = w1;
    VM_DRAIN();
  }
}

#define XB_TMO      128
#define XB_XCNT(j)  (256  + 64 * (j))
#define XB_XSUB(j)  (1280 + 64 * (j))
#define XB_XGEN(j)  (2304 + 64 * (j))
#define XB_TOP      3328
#define XB_TOPGEN   3392
#define XCD_BAR_WORDS 3456
#define XB_SPIN_CAP (1u << 18)
#define LAS __attribute__((address_space(3)))

__device__ __forceinline__ unsigned xb_ld(unsigned* p)              { return __hip_atomic_load(p, __ATOMIC_RELAXED, __HIP_MEMORY_SCOPE_AGENT); }
__device__ __forceinline__ unsigned xb_add(unsigned* p, unsigned v) { return __hip_atomic_fetch_add(p, v, __ATOMIC_RELAXED, __HIP_MEMORY_SCOPE_AGENT); }
__device__ __forceinline__ unsigned xb_xcc_id() { return (unsigned)__builtin_amdgcn_s_getreg((3 << 11) | 20) & 0xFu; }
#define XB_SPIN(cond, bar) do { unsigned _sp = 0; while (cond) { __builtin_amdgcn_s_sleep(1); \
    if ((++_sp & 255u) == 0u) { if (xb_ld(&(bar)[XB_TMO])) break; if (_sp > XB_SPIN_CAP) { atomicAdd(&(bar)[XB_TMO], 1u); break; } } } } while (0)

struct XcdBarrier {
    unsigned* bar; unsigned x;
    volatile LAS unsigned* st;
};

__device__ __forceinline__ XcdBarrier xcd_barrier_post(unsigned* bar, volatile LAS unsigned* st) {
    XcdBarrier b; b.bar = bar; b.x = xb_xcc_id(); b.st = st;
    if (threadIdx.x == 0) (void)xb_add(&bar[XB_XCNT(b.x)], 1u);
    return b;
}
__device__ __forceinline__ void xcd_barrier_complete(unsigned* bar, unsigned x, unsigned& nloc, unsigned& nx) {
    const unsigned G = gridDim.x * gridDim.y * gridDim.z;
    unsigned sum, cnt, mine, sp = 0u;
    for (;;) {
        sum = 0u; cnt = 0u; mine = 0u;
#pragma unroll
        for (unsigned j = 0; j < 16; ++j) { const unsigned c = xb_ld(&bar[XB_XCNT(j)]); sum += c; cnt += (c > 0u) ? 1u : 0u; mine = (j == x) ? c : mine; }
        if (sum == G) break;
        __builtin_amdgcn_s_sleep(1);
        if ((++sp & 255u) == 0u) { if (xb_ld(&bar[XB_TMO])) break; if (sp > XB_SPIN_CAP) { atomicAdd(&bar[XB_TMO], 1u); break; } }
    }
    nloc = mine > 0u ? mine : 1u; nx = cnt > 0u ? cnt : 1u;
}

__device__ __forceinline__ void xcd_barrier(const XcdBarrier& b) {
    asm volatile("s_waitcnt vmcnt(0)" ::: "memory");
    __syncthreads();
    if (threadIdx.x == 0) {
        unsigned* bar = b.bar;
        __builtin_amdgcn_s_waitcnt(0);
        unsigned nloc = b.st[0], nx = b.st[1];
        if (nloc == 0u) { xcd_barrier_complete(bar, b.x, nloc, nx); b.st[0] = nloc; b.st[1] = nx; }
        const unsigned old = xb_add(&bar[XB_XSUB(b.x)], 1u);
        const unsigned gen = old / nloc;
        if (old + 1u == (gen + 1u) * nloc) {
            __builtin_amdgcn_fence(__ATOMIC_RELEASE, "agent");
            asm volatile("s_waitcnt vmcnt(0)" ::: "memory");
            const unsigned og = xb_add(&bar[XB_TOP], 1u);
            const unsigned tg = og / nx;
            if (og + 1u == (tg + 1u) * nx) xb_add(&bar[XB_TOPGEN], 1u);
            else XB_SPIN(xb_ld(&bar[XB_TOPGEN]) == tg, bar);
            __builtin_amdgcn_fence(__ATOMIC_ACQUIRE, "agent");
            xb_add(&bar[XB_XGEN(b.x)], 1u);
            asm volatile("s_waitcnt vmcnt(0)" ::: "memory");
        } else {
            XB_SPIN(xb_ld(&bar[XB_XGEN(b.x)]) == gen, bar);
            __builtin_amdgcn_fence(__ATOMIC_ACQUIRE, "agent");
            asm volatile("s_waitcnt vmcnt(0)" ::: "memory");
        }
    }
    __syncthreads();
}

__global__ void __launch_bounds__(NTHR) mega(Params p, int ph_lo, int ph_hi) {
  extern __shared__ __attribute__((aligned(16))) char lds[];
  cg::grid_group grid = cg::this_grid();
#define GSYNC() do { asm volatile("s_waitcnt vmcnt(0) lgkmcnt(0)" ::: "memory"); __syncthreads(); grid.sync(); __builtin_amdgcn_fence(__ATOMIC_ACQUIRE, "agent"); asm volatile("s_waitcnt vmcnt(0) lgkmcnt(0)" ::: "memory"); __syncthreads(); } while (0)
  const int G = gridDim.x;
  unsigned* bar = reinterpret_cast<unsigned*>(p.ws + WS_STAT);
  volatile LAS unsigned* xst = (volatile LAS unsigned*)(LAS char*)(lds + 149504);
  if (threadIdx.x == 0) { xst[0] = 0u; xst[1] = 0u; }
  __syncthreads();
  XcdBarrier xbar = xcd_barrier_post(bar, xst);
  const int vb = ((G & 7) == 0) ? (int)((blockIdx.x & 7) * (G >> 3) + (blockIdx.x >> 3)) : (int)blockIdx.x;
#define W_ reinterpret_cast<u16*>(p.ws + WS_W)
#define hbuf reinterpret_cast<u16*>(p.ws + WS_H)
#define ybuf reinterpret_cast<u16*>(p.ws + WS_Y)
#define rbuf reinterpret_cast<u16*>(p.ws + WS_R)
#define wmlp (W_ + OFF_WMLP + (size_t)layer * SZ_MLP)
#define wm (W_ + OFF_WMLA + (size_t)j * SZ_MLA)
#define wg (W_ + OFF_WGLA + (size_t)j * SZ_GLA)
#define cq ybuf
#define ckv (ybuf + (size_t)MROWS * 384)
#define krope (ybuf + (size_t)MROWS * 640)
#define qb rbuf
#define kvb (rbuf + (size_t)MROWS * 1536)
#pragma unroll 1
  for (int ph = ph_lo; ph < ph_hi; ++ph) {
    if (ph == 0) {
      phase0(p, vb, G, lds);
    } else if (ph == 33) {
      row_pass(p, 3, 5, 3, -1, 0, 0, 0, false, true);
    } else {
      const int layer = (ph - 1) >> 3, sub = (ph - 1) & 7, j = layer >> 1;
      const bool mla = (layer & 1) == 0;
      if (sub == 0) {
        row_pass(p, layer > 0 ? layer - 1 : -1, 5, 3, layer, 0, 1, 0, layer == 0, false);
      } else if (sub == 1) {
        if (mla) { Epi e{cq, ckv, krope, nullptr, nullptr, nullptr, nullptr};
          gemm_phase<E_MLA1>(hbuf, 1024, wm, 1024, 768, 0, vb, G, lds, e); }
        else { Epi e{rbuf, rbuf + (size_t)MROWS * 1024, rbuf + (size_t)MROWS * 2048, reinterpret_cast<float*>(rbuf + (size_t)MROWS * 3072), nullptr, nullptr, nullptr};
          gemm_phase<E_GLA1>(hbuf, 1024, wg, 1024, 3200, 0, vb, G, lds, e); }
      } else if (sub == 2) {
        if (mla) {
          { Epi e{qb, nullptr, nullptr, nullptr, nullptr, nullptr, nullptr};
            gemm_phase<E_MLAQ>(cq, 384, wm + SZ_MLA_W1, 384, 1536, 0, vb, G, lds, e); }
          { Epi e{kvb, nullptr, nullptr, nullptr, nullptr, nullptr, nullptr};
            gemm_phase<E_MLAKV>(ckv, 256, wm + SZ_MLA_W1 + SZ_MLA_UQ, 256, 2048, 132 * 12, vb, G, lds, e); }
        } else {
          gla_scan(p, j, vb, G, lds);
        }
      } else if (sub == 3) {
        if (mla) attn_phase(p, layer < 3, vb, G, lds);
        else gla_out_pass(p, j);
      } else if (sub == 4) {
        Epi e{ybuf, nullptr, nullptr, nullptr, nullptr, nullptr, nullptr};
        gemm_phase<E_Y, 3>(hbuf, 1024, mla ? wm + SZ_MLA_W1 + SZ_MLA_UQ + SZ_MLA_UKV : wg + SZ_GLA_W1, 1024, 1024, 0, vb, G, lds, e);
      } else if (sub == 5) {
        row_pass(p, layer, 2, 1, layer, 3, 4, 2, false, false);
      } else if (sub == 6) {
        Epi e{rbuf, nullptr, nullptr, nullptr, nullptr, nullptr, nullptr};
        gemm_phase<E_MLP1>(hbuf, 1024, wmlp, 1024, 4096, 0, vb, G, lds, e);
      } else {
        Epi e{ybuf, nullptr, nullptr, nullptr, nullptr, nullptr, nullptr};
        gemm_phase<E_Y, 3>(rbuf, 4096, wmlp + SZ_MLP1, 4096, 1024, 0, vb, G, lds, e);
      }
    }
    if (ph + 1 < ph_hi) {
      if (ph_hi < 0) { GSYNC(); }
      {
        asm volatile("s_waitcnt vmcnt(0) lgkmcnt(0)" ::: "memory");
        xcd_barrier(xbar);
      }
    }
  }
}

#undef W_
#undef hbuf
#undef ybuf
#undef rbuf
#undef wmlp
#undef wm
#undef wg
#undef cq
#undef ckv
#undef krope
#undef qb
#undef kvb
#ifndef N_SPLIT
#define N_SPLIT 1
#endif
extern "C" void kernel_launch(void* const* d_in, const int* in_sizes, int n_in, void* d_out, int out_size, void* d_ws, size_t ws_size, hipStream_t stream) {
  static int grid_blocks = 0;
  if (grid_blocks == 0) {
    if (n_in != 25 || ws_size < WS_END) { fprintf(stderr, "kernel_launch: bad inputs n_in %d ws %zu need %zu\n", n_in, ws_size, (size_t)WS_END); grid_blocks = -1; return; }
    int dev = 0, cus = 0, per_cu = 0;
    (void)hipGetDevice(&dev);
    (void)hipDeviceGetAttribute(&cus, hipDeviceAttributeMultiprocessorCount, dev);
    if (hipFuncSetAttribute((const void*)mega, hipFuncAttributeMaxDynamicSharedMemorySize, LDS_BYTES) != hipSuccess) { fprintf(stderr, "kernel_launch: set LDS attr failed\n"); grid_blocks = -1; return; }
    if (hipOccupancyMaxActiveBlocksPerMultiprocessor(&per_cu, (const void*)mega, NTHR, LDS_BYTES) != hipSuccess || per_cu < 1) { fprintf(stderr, "kernel_launch: occupancy query failed (%d)\n", per_cu); per_cu = 1; }
    (void)hipGetLastError();
    grid_blocks = cus;
  }
  if (grid_blocks < 0) return;
  Params p{};
  const float** pf = reinterpret_cast<const float**>(&p);
  for (int i = 0; i < 25; ++i) pf[i] = (const float*)d_in[i];
  p.out = (float*)d_out; p.ws = (unsigned char*)d_ws;
#ifdef SEQ_LIST
  const int seq_[] = SEQ_LIST;
  for (int li = 0; li < (int)(sizeof(seq_) / sizeof(int)); ++li) {
    int lo = seq_[li], hi = lo + 1;
#else
  (void)hipMemsetAsync((unsigned char*)d_ws + WS_STAT, 0, 16384, stream);
  for (int li = 0; li < N_SPLIT; ++li) {
    int lo = (34 * li) / N_SPLIT, hi = (34 * (li + 1)) / N_SPLIT;
#endif
    void* args[] = {&p, &lo, &hi};
    hipError_t e = hipLaunchCooperativeKernel((const void*)mega, dim3(grid_blocks), dim3(NTHR), args, LDS_BYTES, stream);
    if (e != hipSuccess) { fprintf(stderr, "cooperative launch failed: %s (grid %d)\n", hipGetErrorString(e), grid_blocks); break; }
  }
}
```

```cpp
#include <hip/hip_runtime.h>
#include <hip/hip_cooperative_groups.h>
#include <stdint.h>
#include <cstdio>
namespace cg = cooperative_groups;

typedef unsigned short u16;
using bf16x8 = __attribute__((ext_vector_type(8))) short;
using s16x4  = __attribute__((ext_vector_type(4))) short;
using f32x4  = __attribute__((ext_vector_type(4))) float;
using f32x16 = __attribute__((ext_vector_type(16))) float;
using u32x4  = __attribute__((ext_vector_type(4))) unsigned;
using u32x2  = __attribute__((ext_vector_type(2))) unsigned;
#define DEV __device__ __forceinline__

constexpr int DM = 1024, NBATCH = 4, SEQ = 8192, CTX = 256, TT = SEQ + CTX, MROWS = NBATCH * TT;
constexpr int NTHR = 512;
constexpr float EPS = 1e-6f;

struct Params {
  const float *x, *c, *ctx, *c_ctx, *ada_w, *ada_b, *norm_g, *mlp_w1, *mlp_w2,
      *mla_w_dq, *mla_g_q, *mla_w_uq, *mla_w_dkv, *mla_g_kv, *mla_w_ukv, *mla_w_o,
      *gla_w_q, *gla_w_k, *gla_w_v, *gla_w_r, *gla_w_gate1, *gla_w_gate2, *gla_b_gate, *gla_g_o, *gla_w_o;
  float* out;
  unsigned char* ws;
};

constexpr size_t SZ_MLA_W1 = 768 * 1024, SZ_MLA_UQ = 1536 * 384, SZ_MLA_UKV = 2048 * 256, SZ_WO = 1024 * 1024;
constexpr size_t SZ_MLA = SZ_MLA_W1 + SZ_MLA_UQ + SZ_MLA_UKV + SZ_WO;
constexpr size_t SZ_GLA_W1 = 3200 * 1024, SZ_GLA = SZ_GLA_W1 + SZ_WO;
constexpr size_t SZ_MLP1 = 4096 * 1024, SZ_MLP = 2 * SZ_MLP1;
constexpr size_t OFF_WMLA = 0, OFF_WGLA = 2 * SZ_MLA, OFF_WMLP = OFF_WGLA + 2 * SZ_GLA, W_TOTAL = OFF_WMLP + 4 * SZ_MLP;
constexpr size_t WS_W = 0;
constexpr size_t WS_MOD = WS_W + W_TOTAL * 2;
constexpr size_t WS_XCTX = WS_MOD + 4 * 5 * 6144 * 4;
constexpr size_t WS_STAT = WS_XCTX + (size_t)NBATCH * CTX * DM * 4;
constexpr size_t WS_H = WS_STAT + 4 * (size_t)MROWS * 4;
constexpr size_t WS_Y = WS_H + (size_t)MROWS * 1024 * 2;
constexpr size_t WS_R = WS_Y + (size_t)MROWS * 1024 * 2;
constexpr size_t WS_END = WS_R + (size_t)MROWS * 4096 * 2;
static_assert(WS_MOD % 256 == 0 && WS_H % 256 == 0 && WS_R % 256 == 0, "align");

constexpr int LDS_BYTES = 149520;

DEV u16 f2bf(float f) { unsigned u = __float_as_uint(f); u += 0x7fffu + ((u >> 16) & 1u); return (u16)(u >> 16); }
DEV float bf2f(u16 h) { return __uint_as_float(((unsigned)h) << 16); }
typedef __bf16 bf16x2_t __attribute__((ext_vector_type(2)));
DEV unsigned cvtpk(float lo, float hi) { bf16x2_t v = {(__bf16)lo, (__bf16)hi}; return __builtin_bit_cast(unsigned, v); }
DEV float bflo(unsigned u) { return __uint_as_float(u << 16); }
DEV float bfhi(unsigned u) { return __uint_as_float(u & 0xffff0000u); }
DEV int off128(int row, int ch) { return row * 128 + ((ch ^ ((row >> 1) & 7)) << 4); }
DEV int off256(int row, int ch) { return row * 256 + ((ch ^ (row & 15)) << 4); }
DEV f32x4 mfma16(bf16x8 a, bf16x8 b, f32x4 c) { return __builtin_amdgcn_mfma_f32_16x16x32_bf16(a, b, c, 0, 0, 0); }
DEV float wave_sum(float v) {
  v += __shfl_xor(v, 32); v += __shfl_xor(v, 16); v += __shfl_xor(v, 8); v += __shfl_xor(v, 4); v += __shfl_xor(v, 2); v += __shfl_xor(v, 1);
  return v;
}
#define VM_DRAIN() do { } while (0)
DEV int tidx() { int t = threadIdx.x; asm volatile("" : "+v"(t)); return t; }
DEV float silu_f(float v) { return v / (1.f + __expf(-v)); }
DEV void rope_sc(float pos, int f, float& sn, float& cs) {
  float invf = exp2f(-(float)f * 0.8304820237218406f);
  float rev = pos * invf * 0.15915494309189535f;
  rev = rev - floorf(rev);
  sn = __builtin_amdgcn_sinf(rev); cs = __builtin_amdgcn_cosf(rev);
}
#define rope_rot(A_, B_, POS_, F_) do { float sn_, cs_; rope_sc(POS_, F_, sn_, cs_); float a_ = (A_), b_ = (B_); (A_) = a_ * cs_ - b_ * sn_; (B_) = a_ * sn_ + b_ * cs_; } while (0)

DEV void tr_job(const float* __restrict__ src, int K, int N, u16* __restrict__ dst, const float* __restrict__ kscale, float scalar,
                int& rot, int vb, int G, float* tile) {
  const int tid = tidx();
  const int tn = N >> 6, tk = K >> 6, ntl = tn * tk;
  int start = (vb - (rot % G) + G) % G;
  for (int t = start; t < ntl; t += G) {
    int kb = t / tn, nb = t - kb * tn;
#pragma unroll
    for (int i = 0; i < 2; ++i) {
      int idx = tid + i * 512, r = idx >> 4, c4 = idx & 15;
      float4 v = *reinterpret_cast<const float4*>(src + (size_t)(kb * 64 + r) * N + nb * 64 + c4 * 4);
      float s = scalar * (kscale ? kscale[kb * 64 + r] : 1.f);
      float* tp = tile + r * 65 + c4 * 4;
      tp[0] = v.x * s; tp[1] = v.y * s; tp[2] = v.z * s; tp[3] = v.w * s;
    }
    __syncthreads();
    {
      int n = tid >> 3, k8 = (tid & 7) * 8;
      float e[8];
#pragma unroll
      for (int j = 0; j < 8; ++j) e[j] = tile[(k8 + j) * 65 + n];
      u32x4 w = {cvtpk(e[0], e[1]), cvtpk(e[2], e[3]), cvtpk(e[4], e[5]), cvtpk(e[6], e[7])};
      *reinterpret_cast<u32x4*>(dst + (size_t)(nb * 64 + n) * K + kb * 64 + k8) = w;
    }
    VM_DRAIN();
    __syncthreads();
  }
  rot += ntl;
}

DEV void phase0(const Params& p, int vb, int G, char* lds) {
  const int tid = tidx();
  u16* W = reinterpret_cast<u16*>(p.ws + WS_W);
  float* mod = reinterpret_cast<float*>(p.ws + WS_MOD);
  float* sc = reinterpret_cast<float*>(lds);
  float* red = sc + 5 * 1024;
  float* tile = red + 8 * 5 * 64;
  for (int idx = tid; idx < 5 * 1024; idx += NTHR) {
    int w = idx >> 10, k = idx & 1023;
    float v = (w < 4) ? p.c[w * 1024 + k] : p.c_ctx[k];
    sc[idx] = silu_f(v);
  }
  __syncthreads();
  for (int u = vb; u < 384; u += G) {
    int i = u / 96, n0 = (u - i * 96) * 64, cgi = tid & 63, kg = tid >> 6;
    float a0 = 0, a1 = 0, a2 = 0, a3 = 0, a4 = 0;
    const float* wp = p.ada_w + ((size_t)i * 1024 + kg * 128) * 6144 + n0 + cgi;
#pragma unroll 8
    for (int k = 0; k < 128; ++k) {
      float w = wp[(size_t)k * 6144];
      int kk = kg * 128 + k;
      a0 += sc[kk] * w; a1 += sc[1024 + kk] * w; a2 += sc[2048 + kk] * w; a3 += sc[3072 + kk] * w; a4 += sc[4096 + kk] * w;
    }
    red[(kg * 5 + 0) * 64 + cgi] = a0; red[(kg * 5 + 1) * 64 + cgi] = a1; red[(kg * 5 + 2) * 64 + cgi] = a2;
    red[(kg * 5 + 3) * 64 + cgi] = a3; red[(kg * 5 + 4) * 64 + cgi] = a4;
    __syncthreads();
    if (tid < 320) {
      int w5 = tid >> 6, cc = tid & 63;
      float s = p.ada_b[i * 6144 + n0 + cc];
#pragma unroll
      for (int g = 0; g < 8; ++g) s += red[(g * 5 + w5) * 64 + cc];
      mod[(size_t)(i * 5 + w5) * 6144 + n0 + cc] = s;
    }
    VM_DRAIN();
    __syncthreads();
  }
  int rot = 384;
  for (int j = 0; j < 2; ++j) {
    u16* wm = W + OFF_WMLA + j * SZ_MLA;
    tr_job(p.mla_w_dq + (size_t)j * 1024 * 384, 1024, 384, wm, nullptr, 1.f, rot, vb, G, tile);
    tr_job(p.mla_w_dkv + (size_t)j * 1024 * 320, 1024, 320, wm + 384 * 1024, nullptr, 1.f, rot, vb, G, tile);
    tr_job(p.mla_w_uq + (size_t)j * 384 * 1536, 384, 1536, wm + SZ_MLA_W1, p.mla_g_q + j * 384, 1.f, rot, vb, G, tile);
    tr_job(p.mla_w_ukv + (size_t)j * 256 * 2048, 256, 2048, wm + SZ_MLA_W1 + SZ_MLA_UQ, p.mla_g_kv + j * 256, 1.f, rot, vb, G, tile);
    tr_job(p.mla_w_o + (size_t)j * 1024 * 1024, 1024, 1024, wm + SZ_MLA_W1 + SZ_MLA_UQ + SZ_MLA_UKV, nullptr, 1.f, rot, vb, G, tile);
    u16* wg = W + OFF_WGLA + j * SZ_GLA;
    tr_job(p.gla_w_q + (size_t)j * 1024 * 512, 1024, 512, wg, nullptr, 0.08838834764831845f, rot, vb, G, tile);
    tr_job(p.gla_w_k + (size_t)j * 1024 * 512, 1024, 512, wg + 512 * 1024, nullptr, 1.f, rot, vb, G, tile);
    tr_job(p.gla_w_v + (size_t)j * 1024 * 1024, 1024, 1024, wg + 1024 * 1024, nullptr, 1.f, rot, vb, G, tile);
    tr_job(p.gla_w_r + (size_t)j * 1024 * 1024, 1024, 1024, wg + 2048 * 1024, nullptr, 1.f, rot, vb, G, tile);
    tr_job(p.gla_w_o + (size_t)j * 1024 * 1024, 1024, 1024, wg + SZ_GLA_W1, nullptr, 1.f, rot, vb, G, tile);
    for (int idx = vb * NTHR + tid; idx < 32768; idx += G * NTHR) {
      int dir = idx >> 14, r = (idx >> 10) & 15, k = idx & 1023;
      wg[(size_t)(3072 + dir * 16 + r) * 1024 + k] = f2bf(p.gla_w_gate1[(((size_t)j * 2 + dir) * 1024 + k) * 16 + r]);
    }
    for (int idx = vb * NTHR + tid; idx < 96 * 1024; idx += G * NTHR) wg[(size_t)3104 * 1024 + idx] = 0;
    for (int idx = vb * NTHR + tid; idx < 64 * 1024; idx += G * NTHR) wm[(size_t)704 * 1024 + idx] = 0;
    VM_DRAIN();
  }
  for (int i = 0; i < 4; ++i) {
    u16* wp = W + OFF_WMLP + i * SZ_MLP;
    tr_job(p.mlp_w1 + (size_t)i * 1024 * 4096, 1024, 4096, wp, nullptr, 1.f, rot, vb, G, tile);
    tr_job(p.mlp_w2 + (size_t)i * 4096 * 1024, 4096, 1024, wp + SZ_MLP1, nullptr, 1.f, rot, vb, G, tile);
  }
}

DEV void row_pass(const Params& p, int layer_add, int gate_idx, int gadd_idx,
                  int layer_norm, int sh_idx, int sc_idx, int gnorm_idx, bool first, bool last) {
  const int tid_ = tidx(); const int lane = tid_ & 63;
  const int gw = blockIdx.x * 8 + (tid_ >> 6), nw = gridDim.x * 8;
  const float* mod = reinterpret_cast<const float*>(p.ws + WS_MOD);
  float* xctx = reinterpret_cast<float*>(p.ws + WS_XCTX);
  u16* hbuf = reinterpret_cast<u16*>(p.ws + WS_H);
  const u16* ybuf = reinterpret_cast<const u16*>(p.ws + WS_Y);
  for (int m = gw; m < MROWS; m += nw) {
    int b = m / TT, t = m - b * TT;
    bool isctx = t < CTX;
    int w = isctx ? 4 : b;
    if (last && isctx) continue;
    float* xp = isctx ? xctx + (size_t)(b * CTX + t) * DM : p.out + ((size_t)b * SEQ + (t - CTX)) * DM;
    const float* xin = first ? (isctx ? p.ctx + (size_t)(b * CTX + t) * DM : p.x + ((size_t)b * SEQ + (t - CTX)) * DM) : xp;
    float4 xv[4];
#pragma unroll
    for (int q = 0; q < 4; ++q) xv[q] = *reinterpret_cast<const float4*>(xin + q * 256 + lane * 4);
    if (layer_add >= 0) {
      const float* gate = mod + (size_t)((layer_add * 5 + w) * 6 + gate_idx) * 1024;
      const float* g = p.norm_g + (size_t)(layer_add * 4 + gadd_idx) * 1024;
      u32x2 yy[4]; float ys = 0;
#pragma unroll
      for (int q = 0; q < 4; ++q) {
        yy[q] = *reinterpret_cast<const u32x2*>(ybuf + (size_t)m * 1024 + q * 256 + lane * 4);
        float y0 = bflo(yy[q][0]), y1 = bfhi(yy[q][0]), y2 = bflo(yy[q][1]), y3 = bfhi(yy[q][1]);
        ys += y0 * y0 + y1 * y1 + y2 * y2 + y3 * y3;
      }
      ys = wave_sum(ys);
      const float r = rsqrtf(ys * (1.f / 1024.f) + EPS);
#pragma unroll
      for (int q = 0; q < 4; ++q) {
        int col = q * 256 + lane * 4;
        float4 gt = *reinterpret_cast<const float4*>(gate + col);
        float4 gg = *reinterpret_cast<const float4*>(g + col);
        xv[q].x += gt.x * (gg.x * (bflo(yy[q][0]) * r)); xv[q].y += gt.y * (gg.y * (bfhi(yy[q][0]) * r));
        xv[q].z += gt.z * (gg.z * (bflo(yy[q][1]) * r)); xv[q].w += gt.w * (gg.w * (bfhi(yy[q][1]) * r));
      }
    }
    if (layer_add >= 0 || first) {
#pragma unroll
      for (int q = 0; q < 4; ++q) *reinterpret_cast<float4*>(xp + q * 256 + lane * 4) = xv[q];
    }
    if (layer_norm >= 0) {
      float ss = 0;
#pragma unroll
      for (int q = 0; q < 4; ++q) ss += xv[q].x * xv[q].x + xv[q].y * xv[q].y + xv[q].z * xv[q].z + xv[q].w * xv[q].w;
      ss = wave_sum(ss);
      float r0 = rsqrtf(ss * (1.f / 1024.f) + EPS);
      const float* sh = mod + (size_t)((layer_norm * 5 + w) * 6 + sh_idx) * 1024;
      const float* scl = mod + (size_t)((layer_norm * 5 + w) * 6 + sc_idx) * 1024;
      const float* g = p.norm_g + (size_t)(layer_norm * 4 + gnorm_idx) * 1024;
#pragma unroll
      for (int q = 0; q < 4; ++q) {
        int col = q * 256 + lane * 4;
        float4 s4 = *reinterpret_cast<const float4*>(sh + col);
        float4 c4 = *reinterpret_cast<const float4*>(scl + col);
        float4 gg = *reinterpret_cast<const float4*>(g + col);
        float h0 = (xv[q].x * r0 * gg.x) * (1.f + c4.x) + s4.x, h1 = (xv[q].y * r0 * gg.y) * (1.f + c4.y) + s4.y;
        float h2 = (xv[q].z * r0 * gg.z) * (1.f + c4.z) + s4.z, h3 = (xv[q].w * r0 * gg.w) * (1.f + c4.w) + s4.w;
        u32x2 pk = {cvtpk(h0, h1), cvtpk(h2, h3)};
        *reinterpret_cast<u32x2*>(hbuf + (size_t)m * 1024 + col) = pk;
      }
    }
    VM_DRAIN();
  }
}

DEV u32x4 widen16(u32x2 x, u32x2 y) {
  auto r0 = __builtin_amdgcn_permlane16_swap(x[0], y[0], false, false);
  auto r1 = __builtin_amdgcn_permlane16_swap(x[1], y[1], false, false);
  return u32x4{r0[0], r1[0], r0[1], r1[1]};
}
struct Epi { u16* o0; u16* o1; u16* o2; float* f0; float* s0; float* s1; const float* r0; };
enum { E_Y = 0, E_MLP1 = 1, E_MLA1 = 2, E_MLAQ = 3, E_MLAKV = 4, E_GLA1 = 5 };

template <int EPI, int MT = 4>
DEV void gemm_phase(const u16* __restrict__ A, int lda, const u16* __restrict__ Bt, int K, int N, int rot, int vb, int G, char* lds, const Epi& e) {
  int tid = threadIdx.x; asm volatile("" : "+v"(tid)); const int lane = tid & 63, w = tid >> 6, wm = w >> 1, wn = w & 1, l15 = lane & 15, lq = lane >> 4;
  const int ntn = N >> 7, total = (MROWS / (64 * MT)) * ntn, nk = K >> 6;
  char* As = lds; char* Bs = lds + 98304;
  const int srow = tid >> 3, sch = tid & 7;
  if (__builtin_amdgcn_readfirstlane(w) >= 4) __builtin_amdgcn_s_setprio(1);
  int start = (vb - (rot % G) + G) % G;
  for (int t = start; t < total; t += G) {
    int mb = t / ntn, nb = t - mb * ntn;
    if (MT == 4 && ntn > 8 && (ntn & 7) == 0) {
      const int sidx = t >> 5, j5 = t & 31, scols = ntn >> 3, smb = sidx / scols, snb = sidx - smb * scols;
      mb = smb * 4 + (j5 >> 3); nb = snb * 8 + (j5 & 7);
    }
    const int m0 = mb * (64 * MT), n0 = nb * 128;
    f32x4 acc[4][MT];
    float zf_ = 0.f; asm volatile("" : "+v"(zf_));
#pragma unroll
    for (int i = 0; i < 4; ++i)
#pragma unroll
      for (int j = 0; j < MT; ++j) acc[i][j] = f32x4{zf_, zf_, zf_, zf_};
    auto stage = [&](int kt, int buf) {
#pragma unroll
      for (int i = 0; i < MT; ++i) { const int row = srow + i * 64;
        const u16* g = A + (size_t)(m0 + row) * lda + kt * 64 + ((sch ^ ((row >> 1) & 7)) << 3);
        __builtin_amdgcn_global_load_lds((const unsigned*)g, (unsigned*)(As + buf * 32768 + row * 128 + sch * 16), 16, 0, 0); }
#pragma unroll
      for (int i = 0; i < 2; ++i) { const int row = srow + i * 64;
        const u16* g = Bt + (size_t)(n0 + row) * K + kt * 64 + ((sch ^ ((row >> 1) & 7)) << 3);
        __builtin_amdgcn_global_load_lds((const unsigned*)g, (unsigned*)(Bs + buf * 16384 + row * 128 + sch * 16), 16, 0, 0); }
    };
    __syncthreads();
    if constexpr (EPI == E_MLAQ || EPI == E_MLAKV) {
      const int rrow = tid >> 1, hh = tid & 1, kh = K >> 1;
      const u16* ap = A + (size_t)(m0 + rrow) * lda + hh * kh;
      float ss = 0;
      for (int c = 0; c < kh; c += 8) {
        u32x4 v = *reinterpret_cast<const u32x4*>(ap + c);
#pragma unroll
        for (int z = 0; z < 4; ++z) { float lo = bflo(v[z]), hi2 = bfhi(v[z]); ss += lo * lo + hi2 * hi2; }
      }
      ss += __shfl_xor(ss, 1);
      if (hh == 0) reinterpret_cast<float*>(lds + 147456)[rrow] = rsqrtf(ss / (float)K + EPS);
    }
    asm volatile("s_waitcnt vmcnt(0) lgkmcnt(0)" ::: "memory");
    __syncthreads();
    stage(0, 0); stage(1, 1);
    int cb = 0, pb = 2;
    for (int kt = 0; kt < nk; ++kt) {
      if (kt + 1 < nk) asm volatile("s_waitcnt vmcnt(%0)" :: "n"(MT + 2) : "memory"); else asm volatile("s_waitcnt vmcnt(0)" ::: "memory");
      __builtin_amdgcn_s_barrier();
      __builtin_amdgcn_sched_barrier(0);
      const char* Ac = As + cb * 32768; const char* Bc = Bs + cb * 16384;
      bf16x8 bw[2][4], at[2][MT];
#pragma unroll
      for (int kk = 0; kk < 2; ++kk) {
        const int ch = kk * 4 + lq;
#pragma unroll
        for (int nt = 0; nt < 4; ++nt) bw[kk][nt] = *reinterpret_cast<const bf16x8*>(Bc + off128(wn * 64 + nt * 16 + l15, ch));
#pragma unroll
        for (int mt = 0; mt < MT; ++mt) at[kk][mt] = *reinterpret_cast<const bf16x8*>(Ac + off128(wm * (16 * MT) + mt * 16 + l15, ch));
      }
      __builtin_amdgcn_sched_barrier(0);
      if (kt + 2 < nk) stage(kt + 2, pb);
      __builtin_amdgcn_sched_barrier(0);
#pragma unroll
      for (int kk = 0; kk < 2; ++kk)
#pragma unroll
        for (int nt = 0; nt < 4; ++nt)
#pragma unroll
          for (int mt = 0; mt < MT; ++mt) acc[nt][mt] = mfma16(bw[kk][nt], at[kk][mt], acc[nt][mt]);
      cb = (cb == 2) ? 0 : cb + 1; pb = (pb == 2) ? 0 : pb + 1;
    }
    asm volatile("s_waitcnt lgkmcnt(0)" ::: "memory");
    __syncthreads();
    const int nw = n0 + wn * 64;
    const int mbase = m0 + wm * (16 * MT) + l15;
    const int nl = lq * 4;
    if constexpr (EPI == E_Y) {
#pragma unroll
      for (int mt = 0; mt < MT; ++mt) {
        const int m = mbase + mt * 16;
#pragma unroll
        for (int nt = 0; nt < 4; nt += 2) {
          f32x4 v = acc[nt][mt], v2 = acc[nt + 1][mt];
          u32x4 wv = widen16(u32x2{cvtpk(v[0], v[1]), cvtpk(v[2], v[3])}, u32x2{cvtpk(v2[0], v2[1]), cvtpk(v2[2], v2[3])});
          __builtin_nontemporal_store(wv, reinterpret_cast<u32x4*>(e.o0 + (size_t)m * 1024 + nw + (nt + (lq & 1)) * 16 + (lq & 2) * 4));
        }
      }
    } else if constexpr (EPI == E_MLP1) {
#pragma unroll
      for (int mt = 0; mt < MT; ++mt) {
        const int m = mbase + mt * 16;
#pragma unroll
        for (int nt = 0; nt < 4; nt += 2) {
          f32x4 v = acc[nt][mt], v2 = acc[nt + 1][mt];
#pragma unroll
          for (int j = 0; j < 4; ++j) { float r = fmaxf(v[j], 0.f); v[j] = r * r; float r2 = fmaxf(v2[j], 0.f); v2[j] = r2 * r2; }
          u32x4 wv = widen16(u32x2{cvtpk(v[0], v[1]), cvtpk(v[2], v[3])}, u32x2{cvtpk(v2[0], v2[1]), cvtpk(v2[2], v2[3])});
          __builtin_nontemporal_store(wv, reinterpret_cast<u32x4*>(e.o0 + (size_t)m * 4096 + nw + (nt + (lq & 1)) * 16 + (lq & 2) * 4));
        }
      }
    } else if constexpr (EPI == E_MLA1) {
      if (nw < 640) {
        const bool isq = nw < 384;
#pragma unroll
        for (int mt = 0; mt < MT; ++mt) {
          const int m = mbase + mt * 16;
#pragma unroll
          for (int nt = 0; nt < 4; nt += 2) {
            f32x4 v = acc[nt][mt], v2 = acc[nt + 1][mt];
            u32x4 wv = widen16(u32x2{cvtpk(v[0], v[1]), cvtpk(v[2], v[3])}, u32x2{cvtpk(v2[0], v2[1]), cvtpk(v2[2], v2[3])});
            if (isq) __builtin_nontemporal_store(wv, reinterpret_cast<u32x4*>(e.o0 + (size_t)m * 384 + nw + (nt + (lq & 1)) * 16 + (lq & 2) * 4));
            else     __builtin_nontemporal_store(wv, reinterpret_cast<u32x4*>(e.o1 + (size_t)m * 256 + (nw - 384) + (nt + (lq & 1)) * 16 + (lq & 2) * 4));
          }
        }
      } else if (nw == 640) {
#pragma unroll
        for (int mt = 0; mt < MT; ++mt) {
          const int m = mbase + mt * 16; const int tt = m % TT;
          if (tt >= CTX) {
            const int pos = tt - CTX; const float pr = (float)(pos >> 6), pc = (float)(pos & 63);
#pragma unroll
            for (int j = 0; j < 4; ++j) {
              rope_rot(acc[0][mt][j], acc[1][mt][j], pr, nl + j);
              rope_rot(acc[2][mt][j], acc[3][mt][j], pc, nl + j);
            }
          }
#pragma unroll
          for (int nt = 0; nt < 4; nt += 2) {
            f32x4 v = acc[nt][mt], v2 = acc[nt + 1][mt];
            u32x4 wv = widen16(u32x2{cvtpk(v[0], v[1]), cvtpk(v[2], v[3])}, u32x2{cvtpk(v2[0], v2[1]), cvtpk(v2[2], v2[3])});
            __builtin_nontemporal_store(wv, reinterpret_cast<u32x4*>(e.o2 + (size_t)m * 64 + (nt + (lq & 1)) * 16 + (lq & 2) * 4));
          }
        }
      }
    } else if constexpr (EPI == E_MLAQ) {
      const bool ropet = (nw % 192) == 128;
#pragma unroll
      for (int mt = 0; mt < MT; ++mt) {
        const int m = mbase + mt * 16; const int tt = m % TT;
        const float rs = reinterpret_cast<const float*>(lds + 147456)[wm * 64 + mt * 16 + l15];
#pragma unroll
        for (int nt = 0; nt < 4; ++nt) acc[nt][mt] = acc[nt][mt] * rs;
        if (ropet && tt >= CTX) {
          const int pos = tt - CTX; const float pr = (float)(pos >> 6), pc = (float)(pos & 63);
#pragma unroll
          for (int j = 0; j < 4; ++j) {
            rope_rot(acc[0][mt][j], acc[1][mt][j], pr, nl + j);
            rope_rot(acc[2][mt][j], acc[3][mt][j], pc, nl + j);
          }
        }
#pragma unroll
        for (int nt = 0; nt < 4; nt += 2) {
          f32x4 v = acc[nt][mt], v2 = acc[nt + 1][mt];
          u32x4 wv = widen16(u32x2{cvtpk(v[0], v[1]), cvtpk(v[2], v[3])}, u32x2{cvtpk(v2[0], v2[1]), cvtpk(v2[2], v2[3])});
          __builtin_nontemporal_store(wv, reinterpret_cast<u32x4*>(e.o0 + (size_t)m * 1536 + nw + (nt + (lq & 1)) * 16 + (lq & 2) * 4));
        }
      }
    } else if constexpr (EPI == E_MLAKV) {
#pragma unroll
      for (int mt = 0; mt < MT; ++mt) {
        const int m = mbase + mt * 16;
        const float rs = reinterpret_cast<const float*>(lds + 147456)[wm * 64 + mt * 16 + l15];
#pragma unroll
        for (int nt = 0; nt < 4; nt += 2) {
          f32x4 v = acc[nt][mt] * rs, v2 = acc[nt + 1][mt] * rs;
          u32x4 wv = widen16(u32x2{cvtpk(v[0], v[1]), cvtpk(v[2], v[3])}, u32x2{cvtpk(v2[0], v2[1]), cvtpk(v2[2], v2[3])});
          __builtin_nontemporal_store(wv, reinterpret_cast<u32x4*>(e.o0 + (size_t)m * 2048 + nw + (nt + (lq & 1)) * 16 + (lq & 2) * 4));
        }
      }
    } else if constexpr (EPI == E_GLA1) {
      if (nw < 3072) {
        u16* dst = e.o0 + (size_t)(nw >> 10) * ((size_t)MROWS * 1024);
        const int nc = nw & 1023; const bool dosilu = nw >= 2048;
#pragma unroll
        for (int mt = 0; mt < MT; ++mt) {
          const int m = mbase + mt * 16;
#pragma unroll
          for (int nt = 0; nt < 4; nt += 2) {
            f32x4 v = acc[nt][mt], v2 = acc[nt + 1][mt];
            if (dosilu) {
#pragma unroll
              for (int j = 0; j < 4; ++j) { v[j] = silu_f(v[j]); v2[j] = silu_f(v2[j]); }
            }
            u32x4 wv = widen16(u32x2{cvtpk(v[0], v[1]), cvtpk(v[2], v[3])}, u32x2{cvtpk(v2[0], v2[1]), cvtpk(v2[2], v2[3])});
            __builtin_nontemporal_store(wv, reinterpret_cast<u32x4*>(dst + (size_t)m * 1024 + nc + (nt + (lq & 1)) * 16 + (lq & 2) * 4));
          }
        }
      } else if (nw == 3072) {
#pragma unroll
        for (int mt = 0; mt < MT; ++mt) {
          const int m = mbase + mt * 16;
#pragma unroll
          for (int nt = 0; nt < 2; ++nt) *reinterpret_cast<f32x4*>(e.f0 + (size_t)m * 32 + nt * 16 + nl) = acc[nt][mt];
        }
      }
    }
    VM_DRAIN();
  }
  __builtin_amdgcn_s_setprio(0);
}

constexpr int KVBLK = 64;
constexpr float ATT_SCALE = 0.07216878364870322f;
constexpr float ATT_THR = 8.f;
constexpr int SHM_K = KVBLK * 192 * 2, SHM_V = KVBLK * 128 * 2;
#define KSWZ(row, colB) ((row) * 384 + ((colB) ^ ((((row) >> 1) & 7) << 4)))
#define SBAR() __builtin_amdgcn_sched_barrier(0)
DEV int crow(int r, int hi) { return (r & 3) + 8 * (r >> 2) + 4 * hi; }

DEV void partialSM(f32x16& p0, f32x16& p1, float& m_reg, float& mn, float& alpha) {
  constexpr float C = ATT_SCALE * 1.4426950408889634f;
  float pmax = p0[0];
#pragma unroll
  for (int r = 1; r < 16; ++r) pmax = fmaxf(pmax, p0[r]);
#pragma unroll
  for (int r = 0; r < 16; ++r) pmax = fmaxf(pmax, p1[r]);
  { auto rr = __builtin_amdgcn_permlane32_swap(__float_as_uint(pmax), __float_as_uint(pmax), false, false);
    pmax = fmaxf(__uint_as_float(rr[0]), __uint_as_float(rr[1])); }
  if (__builtin_expect(__all(pmax - m_reg <= ATT_THR / ATT_SCALE), 1)) { mn = m_reg; alpha = 1.f; }
  else { mn = fmaxf(m_reg, pmax); alpha = __builtin_amdgcn_exp2f((m_reg - mn) * C); m_reg = mn; }
  float mnC = -mn * C;
#pragma unroll
  for (int r = 0; r < 16; ++r) p0[r] = fmaf(p0[r], C, mnC);
#pragma unroll
  for (int r = 0; r < 16; ++r) p1[r] = fmaf(p1[r], C, mnC);
#pragma unroll
  for (int r = 0; r < 16; ++r) p0[r] = __builtin_amdgcn_exp2f(p0[r]);
}
DEV void finishSM(f32x16& p0, f32x16& p1, float alpha, float& l_reg, bf16x8& pa0, bf16x8& pa1, bf16x8& pa2, bf16x8& pa3) {
#pragma unroll
  for (int r = 0; r < 16; ++r) p1[r] = __builtin_amdgcn_exp2f(p1[r]);
  float ps = 0;
#pragma unroll
  for (int r = 0; r < 16; ++r) ps += p0[r];
#pragma unroll
  for (int r = 0; r < 16; ++r) ps += p1[r];
  { auto rr = __builtin_amdgcn_permlane32_swap(__float_as_uint(ps), __float_as_uint(ps), false, false);
    ps = __uint_as_float(rr[0]) + __uint_as_float(rr[1]); }
  l_reg = l_reg * alpha + ps;
#define PK4(P, BASE, OUT) do { unsigned a0 = cvtpk(P[BASE + 0], P[BASE + 1]), a1 = cvtpk(P[BASE + 2], P[BASE + 3]);   \
    unsigned b0 = cvtpk(P[BASE + 4], P[BASE + 5]), b1 = cvtpk(P[BASE + 6], P[BASE + 7]);                              \
    auto r0 = __builtin_amdgcn_permlane32_swap(a0, b0, false, false); auto r1 = __builtin_amdgcn_permlane32_swap(a1, b1, false, false); \
    u32x4 w = {r0[0], r1[0], r0[1], r1[1]}; OUT = *reinterpret_cast<bf16x8*>(&w); } while (0)
  PK4(p0, 0, pa0); PK4(p0, 8, pa1); PK4(p1, 0, pa2); PK4(p1, 8, pa3);
#undef PK4
}
DEV void qkt(f32x16& p0, f32x16& p1, const char* Ks, const bf16x8* qr, int r32, int hi) {
  { float zf = 0.f; asm volatile("" : "+v"(zf));
#pragma unroll
    for (int r = 0; r < 16; ++r) { p0[r] = zf; p1[r] = zf; } }
#pragma unroll
  for (int d0 = 0; d0 < 12; ++d0) { int cb = (d0 * 16 + hi * 8) * 2;
    bf16x8 b0 = *reinterpret_cast<const bf16x8*>(Ks + KSWZ(r32, cb));
    bf16x8 b1 = *reinterpret_cast<const bf16x8*>(Ks + KSWZ(32 + r32, cb));
    p0 = __builtin_amdgcn_mfma_f32_32x32x16_bf16(b0, qr[d0], p0, 0, 0, 0);
    p1 = __builtin_amdgcn_mfma_f32_32x32x16_bf16(b1, qr[d0], p1, 0, 0, 0); }
}
DEV int v_st(int k, int c) { const int kk = (k & ~0xC) | ((k & 4) << 1) | ((k & 8) >> 1); return ((kk >> 3) * 4 + (c >> 5)) * 512 + ((kk & 7) * 32 + (c & 31)) * 2; }
DEV int v_rd_base(int lane) { return ((lane & 3) << 3) | (((lane >> 2) & 3) << 6) | (((lane >> 4) & 1) << 5) | (((lane >> 5) & 1) << 8); }
constexpr int v_rd_off(int d0, int ks, int half) { return d0 * 512 + ks * 4096 + half * 2048; }
template <int OFF> DEV s16x4 tr_read(int vb) {
  s16x4 r; asm volatile("ds_read_b64_tr_b16 %0, %1 offset:%2" : "=&v"(r) : "v"(vb), "i"(OFF) : "memory"); return r;
}
template <int D0> DEV void pv_one(f32x16& od, int vb, bf16x8 pa0, bf16x8 pa1, bf16x8 pa2, bf16x8 pa3) {
  s16x4 l0, h0, l1, h1, l2, h2, l3, h3;
  asm volatile("ds_read_b64_tr_b16 %0, %8 offset:%9\n\t"
               "ds_read_b64_tr_b16 %1, %8 offset:%10\n\t"
               "ds_read_b64_tr_b16 %2, %8 offset:%11\n\t"
               "ds_read_b64_tr_b16 %3, %8 offset:%12\n\t"
               "ds_read_b64_tr_b16 %4, %8 offset:%13\n\t"
               "ds_read_b64_tr_b16 %5, %8 offset:%14\n\t"
               "ds_read_b64_tr_b16 %6, %8 offset:%15\n\t"
               "ds_read_b64_tr_b16 %7, %8 offset:%16\n\t"
               "s_waitcnt lgkmcnt(0)"
               : "=&v"(l0), "=&v"(h0), "=&v"(l1), "=&v"(h1), "=&v"(l2), "=&v"(h2), "=&v"(l3), "=&v"(h3)
               : "v"(vb), "i"(v_rd_off(D0, 0, 0)), "i"(v_rd_off(D0, 0, 1)), "i"(v_rd_off(D0, 1, 0)), "i"(v_rd_off(D0, 1, 1)),
                 "i"(v_rd_off(D0, 2, 0)), "i"(v_rd_off(D0, 2, 1)), "i"(v_rd_off(D0, 3, 0)), "i"(v_rd_off(D0, 3, 1))
               : "memory");
  SBAR();
#define PKV(L, H) (bf16x8){L[0], L[1], L[2], L[3], H[0], H[1], H[2], H[3]}
  od = __builtin_amdgcn_mfma_f32_32x32x16_bf16(pa0, PKV(l0, h0), od, 0, 0, 0);
  od = __builtin_amdgcn_mfma_f32_32x32x16_bf16(pa1, PKV(l1, h1), od, 0, 0, 0);
  od = __builtin_amdgcn_mfma_f32_32x32x16_bf16(pa2, PKV(l2, h2), od, 0, 0, 0);
  od = __builtin_amdgcn_mfma_f32_32x32x16_bf16(pa3, PKV(l3, h3), od, 0, 0, 0);
#undef PKV
}
DEV void pv_d0(f32x16* o, int vb, bf16x8 pa0, bf16x8 pa1, bf16x8 pa2, bf16x8 pa3) {
  pv_one<0>(o[0], vb, pa0, pa1, pa2, pa3); pv_one<1>(o[1], vb, pa0, pa1, pa2, pa3); pv_one<2>(o[2], vb, pa0, pa1, pa2, pa3); pv_one<3>(o[3], vb, pa0, pa1, pa2, pa3);
}

DEV void attn_body(const u16* __restrict__ Qb, const u16* __restrict__ Kn, const u16* __restrict__ Kr, const u16* __restrict__ Vh,
                   u16* __restrict__ Ob, int seq, char* lds) {
  int tid = threadIdx.x; asm volatile("" : "+v"(tid)); const int wid = tid >> 6, lane = tid & 63, r32 = lane & 31, hi = lane >> 5;
  char* V_lds = lds; char* K_lds = lds + 2 * SHM_V;
  float* wsl = reinterpret_cast<float*>(lds + 2 * SHM_V + 2 * SHM_K) + wid * 64; float* li_l = wsl; float* al_l = wsl + 32;
  asm volatile("s_waitcnt vmcnt(0) lgkmcnt(0)" ::: "memory");
  __syncthreads();
  float m_reg = -1e30f, l_reg = 0; f32x16 o[4] = {}; bf16x8 qr[12];
  const u16* Qw = Qb + (size_t)(wid * 32 + r32) * 1536 + hi * 8;
#pragma unroll
  for (int d0 = 0; d0 < 12; ++d0) qr[d0] = *reinterpret_cast<const bf16x8*>(Qw + d0 * 16);
  const int sr = tid >> 4, sc = (tid & 15) * 8, vst0 = v_st(sr, sc), vst1 = v_st(32 + sr, sc);
  const int rr_ = tid >> 3, rc_ = (tid & 7) * 8;
  const int vb0 = (int)(uintptr_t)V_lds + v_rd_base(lane);
  bf16x8 vs0, vs1, ks0, ks1, kr0;
#define SLOAD(k0) do { vs0 = *reinterpret_cast<const bf16x8*>(Vh + (size_t)((k0) + sr) * 2048 + sc); vs1 = *reinterpret_cast<const bf16x8*>(Vh + (size_t)((k0) + 32 + sr) * 2048 + sc); \
    ks0 = *reinterpret_cast<const bf16x8*>(Kn + (size_t)((k0) + sr) * 2048 + sc); ks1 = *reinterpret_cast<const bf16x8*>(Kn + (size_t)((k0) + 32 + sr) * 2048 + sc); \
    kr0 = *reinterpret_cast<const bf16x8*>(Kr + (size_t)((k0) + rr_) * 64 + rc_); } while (0)
#define SWRITE(b) do { *reinterpret_cast<bf16x8*>(V_lds + (b) * SHM_V + vst0) = vs0; *reinterpret_cast<bf16x8*>(V_lds + (b) * SHM_V + vst1) = vs1; \
    *reinterpret_cast<bf16x8*>(K_lds + (b) * SHM_K + KSWZ(sr, sc * 2)) = ks0; *reinterpret_cast<bf16x8*>(K_lds + (b) * SHM_K + KSWZ(32 + sr, sc * 2)) = ks1; \
    *reinterpret_cast<bf16x8*>(K_lds + (b) * SHM_K + KSWZ(rr_, 256 + rc_ * 2)) = kr0; } while (0)
#define SWAIT() asm volatile("s_waitcnt vmcnt(0)" ::: "memory")
#define RESC(a) do { if (__any((a) < 1.f)) { if (hi == 0) al_l[r32] = (a); asm volatile("s_waitcnt lgkmcnt(0)" ::: "memory"); \
    _Pragma("unroll") for (int d = 0; d < 4; ++d) _Pragma("unroll") for (int r = 0; r < 16; ++r) o[d][r] *= al_l[crow(r, hi)]; } } while (0)
  f32x16 pA0, pA1; float mnA, alA; bf16x8 pa0, pa1, pa2, pa3; const int NTL = seq / KVBLK;
  SLOAD(0); SWAIT(); SWRITE(0); __syncthreads();
  for (int j = 0; j < NTL; ++j) {
    const int cur = j & 1;
    if (j + 1 < NTL) SLOAD((j + 1) * KVBLK);
    SBAR(); qkt(pA0, pA1, K_lds + cur * SHM_K, qr, r32, hi);
    partialSM(pA0, pA1, m_reg, mnA, alA);
    RESC(alA);
    finishSM(pA0, pA1, alA, l_reg, pa0, pa1, pa2, pa3); SBAR();
    pv_d0(o, vb0 + cur * SHM_V, pa0, pa1, pa2, pa3);
    if (j + 1 < NTL) { SWAIT(); SWRITE(cur ^ 1); }
    __syncthreads();
  }
  if (hi == 0) li_l[r32] = l_reg; asm volatile("s_waitcnt lgkmcnt(0)" ::: "memory");
  u16* Ow = Ob + (size_t)(wid * 32) * 1024;
  unsigned voff = hi * 4096 + r32;
  asm volatile("" : "+v"(voff));
#pragma unroll
  for (int r = 0; r < 16; ++r) { const int cr = (r & 3) + 8 * (r >> 2); float rl = __builtin_amdgcn_rcpf(li_l[cr + 4 * hi]);
    u16* rowp = Ow + cr * 1024;
#pragma unroll
    for (int d0 = 0; d0 < 4; ++d0) rowp[voff + d0 * 32] = f2bf(o[d0][r] * rl); }
  asm volatile("s_waitcnt vmcnt(0) lgkmcnt(0)" ::: "memory");
  __syncthreads();
#undef SLOAD
#undef SWRITE
#undef SWAIT
#undef RESC
}

DEV void attn_phase(const Params& p, bool need_ctx, int vb, int G, char* lds) {
  const u16* q = reinterpret_cast<const u16*>(p.ws + WS_R);
  const u16* kv = q + (size_t)MROWS * 1536;
  const u16* krope = reinterpret_cast<const u16*>(p.ws + WS_Y) + (size_t)MROWS * (384 + 256);
  u16* ob = reinterpret_cast<u16*>(p.ws + WS_H);
  const int nitems = 1024 + (need_ctx ? 32 : 0);
  if (__builtin_amdgcn_readfirstlane((int)(threadIdx.x >> 6)) >= 4) __builtin_amdgcn_s_setprio(1);
  for (int it = vb; it < nitems; it += G) {
    int bh, qrow0, seq;
    if (it < 1024) { bh = it >> 5; qrow0 = CTX + (it & 31) * 256; seq = TT; }
    else { bh = it - 1024; qrow0 = 0; seq = CTX; }
    const int b = bh >> 3, h = bh & 7;
    const size_t r0 = (size_t)b * TT;
    attn_body(q + (r0 + qrow0) * 1536 + h * 192, kv + r0 * 2048 + h * 256, krope + r0 * 64, kv + r0 * 2048 + h * 256 + 128,
              ob + (r0 + qrow0) * 1024 + h * 128, seq, lds);
  }
  __builtin_amdgcn_s_setprio(0);
}

DEV void gla_scan(const Params& p, int lj, int vb, int G, char* lds) {
  int tid = threadIdx.x; asm volatile("" : "+v"(tid)); const int lane = tid & 63, w = tid >> 6, l15 = lane & 15, lq = lane >> 4;
  const u16* qk = reinterpret_cast<const u16*>(p.ws + WS_R);
  const u16* vbuf = qk + (size_t)MROWS * 1024;
  const float* gl = reinterpret_cast<const float*>(p.ws + WS_R + (size_t)MROWS * 1024 * 2 * 3);
  u16* rawQ = reinterpret_cast<u16*>(lds); u16* rawK = reinterpret_cast<u16*>(lds + 16384); u16* rawV = reinterpret_cast<u16*>(lds + 32768);
  float* glS = reinterpret_cast<float*>(lds + 36864);
  char* qt = lds + 40960; char* kt = lds + 57344; char* kendT = lds + 73728; char* vT = lds + 90112; char* Ab = lds + 94208; char* ST = lds + 102400;
  float* decS = reinterpret_cast<float*>(lds + 110592); float* gsum = reinterpret_cast<float*>(lds + 111104);
  const int d = tid & 127, ig = tid >> 7;
  for (int u = vb; u < 256; u += G) {
    const int s = u & 7, dir = (u >> 3) & 1, h = (u >> 4) & 3, b = u >> 6;
    u16* odir = reinterpret_cast<u16*>(p.ws + (dir == 0 ? WS_H : WS_Y));
    const int dg = w * 16 + l15;
    bf16x8 w2f;
    { float wv_[8];
#pragma unroll
      for (int jj = 0; jj < 8; ++jj) { const int r = (lq & 1) * 8 + jj;
        const float v = p.gla_w_gate2[((size_t)(lj * 2 + dir) * 16 + r) * 512 + h * 128 + dg]; wv_[jj] = (lq < 2) ? v : 0.f; }
      u32x4 wv4 = {cvtpk(wv_[0], wv_[1]), cvtpk(wv_[2], wv_[3]), cvtpk(wv_[4], wv_[5]), cvtpk(wv_[6], wv_[7])};
      w2f = *reinterpret_cast<bf16x8*>(&wv4); }
    const float bias = p.gla_b_gate[(size_t)(lj * 2 + dir) * 512 + h * 128 + dg];
    f32x4 Sacc[2] = {f32x4{0, 0, 0, 0}, f32x4{0, 0, 0, 0}};
    __syncthreads();
    *reinterpret_cast<u32x4*>(ST + tid * 16) = u32x4{0, 0, 0, 0};
    bf16x8 pq[2], pk[2]; u32x4 pv;
    auto rowof = [&](int n, int i) -> size_t { int pp = n * 64 + i; int t = (dir == 0) ? pp : (pp < CTX ? (CTX - 1 - pp) : (TT + CTX - 1 - pp)); return (size_t)b * TT + t; };
    auto gload = [&](int n) {
#pragma unroll
      for (int x = 0; x < 2; ++x) { int c = tid + x * 512, i = c >> 4, ch = c & 15; size_t row = rowof(n, i);
        pq[x] = *reinterpret_cast<const bf16x8*>(qk + row * 1024 + h * 128 + ch * 8);
        pk[x] = *reinterpret_cast<const bf16x8*>(qk + row * 1024 + 512 + h * 128 + ch * 8); }
      if (tid < 256) { int i = tid >> 2, ch = tid & 3; pv = *reinterpret_cast<const u32x4*>(vbuf + rowof(n, i) * 1024 + h * 256 + s * 32 + ch * 8); }
      else { int i = (tid - 256) >> 2, ch = tid & 3; pv = *reinterpret_cast<const u32x4*>(gl + rowof(n, i) * 32 + dir * 16 + ch * 4); }
    };
    auto lstore = [&]() {
#pragma unroll
      for (int x = 0; x < 2; ++x) { int c = tid + x * 512, i = c >> 4, ch = c & 15;
        *reinterpret_cast<bf16x8*>(rawQ + i * 128 + ch * 8) = pq[x]; *reinterpret_cast<bf16x8*>(rawK + i * 128 + ch * 8) = pk[x]; }
      if (tid < 256) { int i = tid >> 2, ch = tid & 3; *reinterpret_cast<u32x4*>(rawV + i * 32 + ch * 8) = pv; }
      else { int i = (tid - 256) >> 2, ch = tid & 3; *reinterpret_cast<u32x4*>(glS + i * 16 + ch * 4) = pv; }
    };
    gload(0); lstore();
    const int it = w >> 1, wv = w & 1;
    for (int n = 0; n < 132; ++n) {
      VM_DRAIN();
      __syncthreads();
      if (n + 1 < 132) gload(n + 1);
      float gq[4][4];
#pragma unroll
      for (int tt = 0; tt < 4; ++tt) {
        const float* gp = glS + (tt * 16 + l15) * 16 + (lq & 1) * 8;
        f32x4 g0 = *reinterpret_cast<const f32x4*>(gp), g1 = *reinterpret_cast<const f32x4*>(gp + 4);
        if (lq >= 2) { g0 = f32x4{0, 0, 0, 0}; g1 = f32x4{0, 0, 0, 0}; }
        u32x4 ga = {cvtpk(g0[0], g0[1]), cvtpk(g0[2], g0[3]), cvtpk(g1[0], g1[1]), cvtpk(g1[2], g1[3])};
        f32x4 xa = mfma16(*reinterpret_cast<bf16x8*>(&ga), w2f, f32x4{0, 0, 0, 0});
#pragma unroll
        for (int j = 0; j < 4; ++j) { const float xg = xa[j] + bias;
          gq[tt][j] = (fminf(xg, 0.f) - __logf(1.f + __expf(-fabsf(xg)))) * (1.f / 16.f); }
      }
      float base = 0.f, tot = 0.f;
#pragma unroll
      for (int tt = 0; tt < 4; ++tt) {
        gq[tt][1] += gq[tt][0]; gq[tt][2] += gq[tt][1]; gq[tt][3] += gq[tt][2];
        const float T = gq[tt][3];
        const float u1 = __shfl(T, (lane - 16) & 63), u2 = __shfl(T, (lane - 32) & 63), u3 = __shfl(T, (lane - 48) & 63);
        const float E = (lq >= 1 ? u1 : 0.f) + (lq >= 2 ? u2 : 0.f) + (lq >= 3 ? u3 : 0.f);
        float S = T + __shfl_xor(T, 16); S += __shfl_xor(S, 32);
#pragma unroll
        for (int j = 0; j < 4; ++j) gq[tt][j] += base + E;
        base += S;
      }
      tot = base;
      if (lq == 0) decS[dg] = __expf(tot);
#pragma unroll
      for (int tt = 0; tt < 4; ++tt) {
        float ke[4];
#pragma unroll
        for (int j = 0; j < 4; ++j) {
          const int i = tt * 16 + lq * 4 + j; const float Gv = gq[tt][j];
          const float qv = bf2f(rawQ[i * 128 + dg]), kvv = bf2f(rawK[i * 128 + dg]);
          *reinterpret_cast<u16*>(qt + off256(i, dg >> 3) + (dg & 7) * 2) = f2bf(qv * __expf(Gv));
          *reinterpret_cast<u16*>(kt + off256(i, dg >> 3) + (dg & 7) * 2) = f2bf(kvv * __expf(-Gv));
          ke[j] = kvv * __expf(tot - Gv);
        }
        *reinterpret_cast<u32x2*>(kendT + off128(dg, tt * 2 + (lq >> 1)) + (lq & 1) * 8) = u32x2{cvtpk(ke[0], ke[1]), cvtpk(ke[2], ke[3])};
      }
      { const int vc = tid & 31, jg = tid >> 5;
        unsigned a0 = rawV[(jg * 4 + 0) * 32 + vc], a1 = rawV[(jg * 4 + 1) * 32 + vc], a2 = rawV[(jg * 4 + 2) * 32 + vc], a3 = rawV[(jg * 4 + 3) * 32 + vc];
        *reinterpret_cast<u32x2*>(vT + off128(vc, jg >> 1) + (jg & 1) * 8) = u32x2{a0 | (a1 << 16), a2 | (a3 << 16)}; }
      __syncthreads();
      if (n + 1 < 132) lstore();
      f32x4 oacc = f32x4{0, 0, 0, 0};
      bf16x8 qa[4];
#pragma unroll
      for (int ks = 0; ks < 4; ++ks) qa[ks] = *reinterpret_cast<const bf16x8*>(qt + off256(it * 16 + l15, ks * 4 + lq));
#pragma unroll
      for (int ks = 0; ks < 4; ++ks) { bf16x8 bb = *reinterpret_cast<const bf16x8*>(ST + off256(wv * 16 + l15, ks * 4 + lq)); oacc = mfma16(qa[ks], bb, oacc); }
#pragma unroll
      for (int x = 0; x < 2; ++x) {
        const int jt = wv * 2 + x; f32x4 aacc = f32x4{0, 0, 0, 0};
        if (jt <= it) {
#pragma unroll
          for (int ks = 0; ks < 4; ++ks) { bf16x8 bb = *reinterpret_cast<const bf16x8*>(kt + off256(jt * 16 + l15, ks * 4 + lq)); aacc = mfma16(qa[ks], bb, aacc); }
        }
#pragma unroll
        for (int jj = 0; jj < 4; ++jj) { const int i = it * 16 + lq * 4 + jj, j = jt * 16 + l15;
          *reinterpret_cast<u16*>(Ab + off128(i, j >> 3) + (j & 7) * 2) = f2bf(j <= i ? aacc[jj] : 0.f); }
      }
      __syncthreads();
#pragma unroll
      for (int ks = 0; ks < 2; ++ks) { bf16x8 a = *reinterpret_cast<const bf16x8*>(Ab + off128(it * 16 + l15, ks * 4 + lq));
        bf16x8 bb = *reinterpret_cast<const bf16x8*>(vT + off128(wv * 16 + l15, ks * 4 + lq)); oacc = mfma16(a, bb, oacc); }
#pragma unroll
      for (int jj = 0; jj < 4; ++jj) { const int i = it * 16 + lq * 4 + jj;
        odir[rowof(n, i) * 1024 + h * 256 + s * 32 + wv * 16 + l15] = f2bf(oacc[jj]); }
      f32x4 dv = *reinterpret_cast<const f32x4*>(decS + w * 16 + lq * 4);
      bf16x8 ka[2];
#pragma unroll
      for (int ks = 0; ks < 2; ++ks) ka[ks] = *reinterpret_cast<const bf16x8*>(kendT + off128(w * 16 + l15, ks * 4 + lq));
#pragma unroll
      for (int vt = 0; vt < 2; ++vt) {
        Sacc[vt] = Sacc[vt] * dv;
#pragma unroll
        for (int ks = 0; ks < 2; ++ks) { bf16x8 bb = *reinterpret_cast<const bf16x8*>(vT + off128(vt * 16 + l15, ks * 4 + lq)); Sacc[vt] = mfma16(ka[ks], bb, Sacc[vt]); }
        *reinterpret_cast<u32x2*>(ST + off256(vt * 16 + l15, w * 2 + (lq >> 1)) + (lq & 1) * 8) = u32x2{cvtpk(Sacc[vt][0], Sacc[vt][1]), cvtpk(Sacc[vt][2], Sacc[vt][3])};
      }
    }
  }
}

DEV void gla_out_pass(const Params& p, int lj) {
  const int tid_ = tidx(); const int lane = tid_ & 63;
  const int gw = blockIdx.x * 8 + (tid_ >> 6), nw = gridDim.x * 8;
  u16* of = reinterpret_cast<u16*>(p.ws + WS_H);
  const u16* ob = reinterpret_cast<const u16*>(p.ws + WS_Y);
  const u16* rb = reinterpret_cast<const u16*>(p.ws + WS_R) + (size_t)MROWS * 2048;
  float go[16];
#pragma unroll
  for (int j = 0; j < 4; ++j) { float4 g4 = *reinterpret_cast<const float4*>(p.gla_g_o + lj * 256 + (lane & 15) * 16 + j * 4); go[j * 4] = g4.x; go[j * 4 + 1] = g4.y; go[j * 4 + 2] = g4.z; go[j * 4 + 3] = g4.w; }
  for (int m = gw; m < MROWS; m += nw) {
    const size_t base = (size_t)m * 1024 + lane * 16;
    u32x4 f0 = *reinterpret_cast<const u32x4*>(of + base), f1 = *reinterpret_cast<const u32x4*>(of + base + 8);
    u32x4 b0 = *reinterpret_cast<const u32x4*>(ob + base), b1 = *reinterpret_cast<const u32x4*>(ob + base + 8);
    u32x4 r0 = *reinterpret_cast<const u32x4*>(rb + base), r1 = *reinterpret_cast<const u32x4*>(rb + base + 8);
    float o[16], rr[16];
#pragma unroll
    for (int j = 0; j < 4; ++j) {
      o[2 * j] = bflo(f0[j]) + bflo(b0[j]); o[2 * j + 1] = bfhi(f0[j]) + bfhi(b0[j]);
      o[8 + 2 * j] = bflo(f1[j]) + bflo(b1[j]); o[8 + 2 * j + 1] = bfhi(f1[j]) + bfhi(b1[j]);
      rr[2 * j] = bflo(r0[j]); rr[2 * j + 1] = bfhi(r0[j]); rr[8 + 2 * j] = bflo(r1[j]); rr[8 + 2 * j + 1] = bfhi(r1[j]);
    }
    float ss = 0;
#pragma unroll
    for (int j = 0; j < 16; ++j) ss += o[j] * o[j];
    ss += __shfl_xor(ss, 8); ss += __shfl_xor(ss, 4); ss += __shfl_xor(ss, 2); ss += __shfl_xor(ss, 1);
    const float rs = rsqrtf(ss * (1.f / 256.f) + EPS);
    float y[16];
#pragma unroll
    for (int j = 0; j < 16; ++j) y[j] = (o[j] * rs * go[j]) * rr[j];
    u32x4 w0 = {cvtpk(y[0], y[1]), cvtpk(y[2], y[3]), cvtpk(y[4], y[5]), cvtpk(y[6], y[7])};
    u32x4 w1 = {cvtpk(y[8], y[9]), cvtpk(y[10], y[11]), cvtpk(y[12], y[13]), cvtpk(y[14], y[15])};
    *reinterpret_cast<u32x4*>(of + base) = w0; *reinterpret_cast<u32x4*>(of + base + 8) = w1;
    VM_DRAIN();
  }
}

#define XB_TMO      128
#define XB_XCNT(j)  (256  + 64 * (j))
#define XB_XSUB(j)  (1280 + 64 * (j))
#define XB_XGEN(j)  (2304 + 64 * (j))
#define XB_TOP      3328
#define XB_TOPGEN   3392
#define XCD_BAR_WORDS 3456
#define XB_SPIN_CAP (1u << 18)
#define LAS __attribute__((address_space(3)))

__device__ __forceinline__ unsigned xb_ld(unsigned* p)              { return __hip_atomic_load(p, __ATOMIC_RELAXED, __HIP_MEMORY_SCOPE_AGENT); }
__device__ __forceinline__ unsigned xb_add(unsigned* p, unsigned v) { return __hip_atomic_fetch_add(p, v, __ATOMIC_RELAXED, __HIP_MEMORY_SCOPE_AGENT); }
__device__ __forceinline__ unsigned xb_xcc_id() { return (unsigned)__builtin_amdgcn_s_getreg((3 << 11) | 20) & 0xFu; }
#define XB_SPIN(cond, bar) do { unsigned _sp = 0; while (cond) { __builtin_amdgcn_s_sleep(1); \
    if ((++_sp & 255u) == 0u) { if (xb_ld(&(bar)[XB_TMO])) break; if (_sp > XB_SPIN_CAP) { atomicAdd(&(bar)[XB_TMO], 1u); break; } } } } while (0)

struct XcdBarrier {
    unsigned* bar; unsigned x;
    volatile LAS unsigned* st;
};

__device__ __forceinline__ XcdBarrier xcd_barrier_post(unsigned* bar, volatile LAS unsigned* st) {
    XcdBarrier b; b.bar = bar; b.x = xb_xcc_id(); b.st = st;
    if (threadIdx.x == 0) (void)xb_add(&bar[XB_XCNT(b.x)], 1u);
    return b;
}
__device__ __forceinline__ void xcd_barrier_complete(unsigned* bar, unsigned x, unsigned& nloc, unsigned& nx) {
    const unsigned G = gridDim.x * gridDim.y * gridDim.z;
    unsigned sum, cnt, mine, sp = 0u;
    for (;;) {
        sum = 0u; cnt = 0u; mine = 0u;
#pragma unroll
        for (unsigned j = 0; j < 16; ++j) { const unsigned c = xb_ld(&bar[XB_XCNT(j)]); sum += c; cnt += (c > 0u) ? 1u : 0u; mine = (j == x) ? c : mine; }
        if (sum == G) break;
        __builtin_amdgcn_s_sleep(1);
        if ((++sp & 255u) == 0u) { if (xb_ld(&bar[XB_TMO])) break; if (sp > XB_SPIN_CAP) { atomicAdd(&bar[XB_TMO], 1u); break; } }
    }
    nloc = mine > 0u ? mine : 1u; nx = cnt > 0u ? cnt : 1u;
}

__device__ __forceinline__ void xcd_barrier(const XcdBarrier& b) {
    asm volatile("s_waitcnt vmcnt(0)" ::: "memory");
    __syncthreads();
    if (threadIdx.x == 0) {
        unsigned* bar = b.bar;
        __builtin_amdgcn_s_waitcnt(0);
        unsigned nloc = b.st[0], nx = b.st[1];
        if (nloc == 0u) { xcd_barrier_complete(bar, b.x, nloc, nx); b.st[0] = nloc; b.st[1] = nx; }
        const unsigned old = xb_add(&bar[XB_XSUB(b.x)], 1u);
        const unsigned gen = old / nloc;
        if (old + 1u == (gen + 1u) * nloc) {
            __builtin_amdgcn_fence(__ATOMIC_RELEASE, "agent");
            asm volatile("s_waitcnt vmcnt(0)" ::: "memory");
            const unsigned og = xb_add(&bar[XB_TOP], 1u);
            const unsigned tg = og / nx;
            if (og + 1u == (tg + 1u) * nx) xb_add(&bar[XB_TOPGEN], 1u);
            else XB_SPIN(xb_ld(&bar[XB_TOPGEN]) == tg, bar);
            __builtin_amdgcn_fence(__ATOMIC_ACQUIRE, "agent");
            xb_add(&bar[XB_XGEN(b.x)], 1u);
            asm volatile("s_waitcnt vmcnt(0)" ::: "memory");
        } else {
            XB_SPIN(xb_ld(&bar[XB_XGEN(b.x)]) == gen, bar);
            __builtin_amdgcn_fence(__ATOMIC_ACQUIRE, "agent");
            asm volatile("s_waitcnt vmcnt(0)" ::: "memory");
        }
    }
    __syncthreads();
}

__global__ void __launch_bounds__(NTHR) mega(Params p, int ph_lo, int ph_hi) {
  extern __shared__ __attribute__((aligned(16))) char lds[];
  cg::grid_group grid = cg::this_grid();
#define GSYNC() do { asm volatile("s_waitcnt vmcnt(0) lgkmcnt(0)" ::: "memory"); __syncthreads(); grid.sync(); __builtin_amdgcn_fence(__ATOMIC_ACQUIRE, "agent"); asm volatile("s_waitcnt vmcnt(0) lgkmcnt(0)" ::: "memory"); __syncthreads(); } while (0)
  const int G = gridDim.x;
  unsigned* bar = reinterpret_cast<unsigned*>(p.ws + WS_STAT);
  volatile LAS unsigned* xst = (volatile LAS unsigned*)(LAS char*)(lds + 149504);
  if (threadIdx.x == 0) { xst[0] = 0u; xst[1] = 0u; }
  __syncthreads();
  XcdBarrier xbar = xcd_barrier_post(bar, xst);
  const int vb = ((G & 7) == 0) ? (int)((blockIdx.x & 7) * (G >> 3) + (blockIdx.x >> 3)) : (int)blockIdx.x;
#define W_ reinterpret_cast<u16*>(p.ws + WS_W)
#define hbuf reinterpret_cast<u16*>(p.ws + WS_H)
#define ybuf reinterpret_cast<u16*>(p.ws + WS_Y)
#define rbuf reinterpret_cast<u16*>(p.ws + WS_R)
#define wmlp (W_ + OFF_WMLP + (size_t)layer * SZ_MLP)
#define wm (W_ + OFF_WMLA + (size_t)j * SZ_MLA)
#define wg (W_ + OFF_WGLA + (size_t)j * SZ_GLA)
#define cq ybuf
#define ckv (ybuf + (size_t)MROWS * 384)
#define krope (ybuf + (size_t)MROWS * 640)
#define qb rbuf
#define kvb (rbuf + (size_t)MROWS * 1536)
#pragma unroll 1
  for (int ph = ph_lo; ph < ph_hi; ++ph) {
    if (ph == 0) {
      phase0(p, vb, G, lds);
    } else if (ph == 33) {
      row_pass(p, 3, 5, 3, -1, 0, 0, 0, false, true);
    } else {
      const int layer = (ph - 1) >> 3, sub = (ph - 1) & 7, j = layer >> 1;
      const bool mla = (layer & 1) == 0;
      if (sub == 0) {
        row_pass(p, layer > 0 ? layer - 1 : -1, 5, 3, layer, 0, 1, 0, layer == 0, false);
      } else if (sub == 1) {
        if (mla) { Epi e{cq, ckv, krope, nullptr, nullptr, nullptr, nullptr};
          gemm_phase<E_MLA1>(hbuf, 1024, wm, 1024, 768, 0, vb, G, lds, e); }
        else { Epi e{rbuf, rbuf + (size_t)MROWS * 1024, rbuf + (size_t)MROWS * 2048, reinterpret_cast<float*>(rbuf + (size_t)MROWS * 3072), nullptr, nullptr, nullptr};
          gemm_phase<E_GLA1>(hbuf, 1024, wg, 1024, 3200, 0, vb, G, lds, e); }
      } else if (sub == 2) {
        if (mla) {
          { Epi e{qb, nullptr, nullptr, nullptr, nullptr, nullptr, nullptr};
            gemm_phase<E_MLAQ>(cq, 384, wm + SZ_MLA_W1, 384, 1536, 0, vb, G, lds, e); }
          { Epi e{kvb, nullptr, nullptr, nullptr, nullptr, nullptr, nullptr};
            gemm_phase<E_MLAKV>(ckv, 256, wm + SZ_MLA_W1 + SZ_MLA_UQ, 256, 2048, 132 * 12, vb, G, lds, e); }
        } else {
          gla_scan(p, j, vb, G, lds);
        }
      } else if (sub == 3) {
        if (mla) attn_phase(p, layer < 3, vb, G, lds);
        else gla_out_pass(p, j);
      } else if (sub == 4) {
        Epi e{ybuf, nullptr, nullptr, nullptr, nullptr, nullptr, nullptr};
        gemm_phase<E_Y, 3>(hbuf, 1024, mla ? wm + SZ_MLA_W1 + SZ_MLA_UQ + SZ_MLA_UKV : wg + SZ_GLA_W1, 1024, 1024, 0, vb, G, lds, e);
      } else if (sub == 5) {
        row_pass(p, layer, 2, 1, layer, 3, 4, 2, false, false);
      } else if (sub == 6) {
        Epi e{rbuf, nullptr, nullptr, nullptr, nullptr, nullptr, nullptr};
        gemm_phase<E_MLP1>(hbuf, 1024, wmlp, 1024, 4096, 0, vb, G, lds, e);
      } else {
        Epi e{ybuf, nullptr, nullptr, nullptr, nullptr, nullptr, nullptr};
        gemm_phase<E_Y, 3>(rbuf, 4096, wmlp + SZ_MLP1, 4096, 1024, 0, vb, G, lds, e);
      }
    }
    if (ph + 1 < ph_hi) {
      if (ph_hi < 0) { GSYNC(); }
      {
        asm volatile("s_waitcnt vmcnt(0) lgkmcnt(0)" ::: "memory");
        xcd_barrier(xbar);
      }
    }
  }
}

#undef W_
#undef hbuf
#undef ybuf
#undef rbuf
#undef wmlp
#undef wm
#undef wg
#undef cq
#undef ckv
#undef krope
#undef qb
#undef kvb
#ifndef N_SPLIT
#define N_SPLIT 1
#endif
extern "C" void kernel_launch(void* const* d_in, const int* in_sizes, int n_in, void* d_out, int out_size, void* d_ws, size_t ws_size, hipStream_t stream) {
  static int grid_blocks = 0;
  if (grid_blocks == 0) {
    if (n_in != 25 || ws_size < WS_END) { fprintf(stderr, "kernel_launch: bad inputs n_in %d ws %zu need %zu\n", n_in, ws_size, (size_t)WS_END); grid_blocks = -1; return; }
    int dev = 0, cus = 0, per_cu = 0;
    (void)hipGetDevice(&dev);
    (void)hipDeviceGetAttribute(&cus, hipDeviceAttributeMultiprocessorCount, dev);
    if (hipFuncSetAttribute((const void*)mega, hipFuncAttributeMaxDynamicSharedMemorySize, LDS_BYTES) != hipSuccess) { fprintf(stderr, "kernel_launch: set LDS attr failed\n"); grid_blocks = -1; return; }
    if (hipOccupancyMaxActiveBlocksPerMultiprocessor(&per_cu, (const void*)mega, NTHR, LDS_BYTES) != hipSuccess || per_cu < 1) { fprintf(stderr, "kernel_launch: occupancy query failed (%d)\n", per_cu); per_cu = 1; }
    (void)hipGetLastError();
    grid_blocks = cus;
  }
  if (grid_blocks < 0) return;
  Params p{};
  const float** pf = reinterpret_cast<const float**>(&p);
  for (int i = 0; i < 25; ++i) pf[i] = (const float*)d_in[i];
  p.out = (float*)d_out; p.ws = (unsigned char*)d_ws;
#ifdef SEQ_LIST
  const int seq_[] = SEQ_LIST;
  for (int li = 0; li < (int)(sizeof(seq_) / sizeof(int)); ++li) {
    int lo = seq_[li], hi = lo + 1;
#else
  (void)hipMemsetAsync((unsigned char*)d_ws + WS_STAT, 0, 16384, stream);
  for (int li = 0; li < N_SPLIT; ++li) {
    int lo = (34 * li) / N_SPLIT, hi = (34 * (li + 1)) / N_SPLIT;
#endif
    void* args[] = {&p, &lo, &hi};
    hipError_t e = hipLaunchCooperativeKernel((const void*)mega, dim3(grid_blocks), dim3(NTHR), args, LDS_BYTES, stream);
    if (e != hipSuccess) { fprintf(stderr, "cooperative launch failed: %s (grid %d)\n", hipGetErrorString(e), grid_blocks); break; }
  }
}
```

```cpp
#include <hip/hip_runtime.h>
#include <hip/hip_cooperative_groups.h>
#include <stdint.h>
#include <cstdio>
namespace cg = cooperative_groups;

typedef unsigned short u16;
using bf16x8 = __attribute__((ext_vector_type(8))) short;
using s16x4  = __attribute__((ext_vector_type(4))) short;
using f32x4  = __attribute__((ext_vector_type(4))) float;
using f32x16 = __attribute__((ext_vector_type(16))) float;
using u32x4  = __attribute__((ext_vector_type(4))) unsigned;
using u32x2  = __attribute__((ext_vector_type(2))) unsigned;
#define DEV __device__ __forceinline__

constexpr int DM = 1024, NBATCH = 4, SEQ = 8192, CTX = 256, TT = SEQ + CTX, MROWS = NBATCH * TT;
constexpr int NTHR = 512;
constexpr float EPS = 1e-6f;

struct Params {
  const float *x, *c, *ctx, *c_ctx, *ada_w, *ada_b, *norm_g, *mlp_w1, *mlp_w2,
      *mla_w_dq, *mla_g_q, *mla_w_uq, *mla_w_dkv, *mla_g_kv, *mla_w_ukv, *mla_w_o,
      *gla_w_q, *gla_w_k, *gla_w_v, *gla_w_r, *gla_w_gate1, *gla_w_gate2, *gla_b_gate, *gla_g_o, *gla_w_o;
  float* out;
  unsigned char* ws;
};

constexpr size_t SZ_MLA_W1 = 768 * 1024, SZ_MLA_UQ = 1536 * 384, SZ_MLA_UKV = 2048 * 256, SZ_WO = 1024 * 1024;
constexpr size_t SZ_MLA = SZ_MLA_W1 + SZ_MLA_UQ + SZ_MLA_UKV + SZ_WO;
constexpr size_t SZ_GLA_W1 = 3200 * 1024, SZ_GLA = SZ_GLA_W1 + SZ_WO;
constexpr size_t SZ_MLP1 = 4096 * 1024, SZ_MLP = 2 * SZ_MLP1;
constexpr size_t OFF_WMLA = 0, OFF_WGLA = 2 * SZ_MLA, OFF_WMLP = OFF_WGLA + 2 * SZ_GLA, W_TOTAL = OFF_WMLP + 4 * SZ_MLP;
constexpr size_t WS_W = 0;
constexpr size_t WS_MOD = WS_W + W_TOTAL * 2;
constexpr size_t WS_XCTX = WS_MOD + 4 * 5 * 6144 * 4;
constexpr size_t WS_STAT = WS_XCTX + (size_t)NBATCH * CTX * DM * 4;
constexpr size_t WS_H = WS_STAT + 4 * (size_t)MROWS * 4;
constexpr size_t WS_Y = WS_H + (size_t)MROWS * 1024 * 2;
constexpr size_t WS_R = WS_Y + (size_t)MROWS * 1024 * 2;
constexpr size_t WS_END = WS_R + (size_t)MROWS * 4096 * 2;
static_assert(WS_MOD % 256 == 0 && WS_H % 256 == 0 && WS_R % 256 == 0, "align");

constexpr int LDS_BYTES = 149520;

DEV u16 f2bf(float f) { unsigned u = __float_as_uint(f); u += 0x7fffu + ((u >> 16) & 1u); return (u16)(u >> 16); }
DEV float bf2f(u16 h) { return __uint_as_float(((unsigned)h) << 16); }
typedef __bf16 bf16x2_t __attribute__((ext_vector_type(2)));
DEV unsigned cvtpk(float lo, float hi) { bf16x2_t v = {(__bf16)lo, (__bf16)hi}; return __builtin_bit_cast(unsigned, v); }
DEV float bflo(unsigned u) { return __uint_as_float(u << 16); }
DEV float bfhi(unsigned u) { return __uint_as_float(u & 0xffff0000u); }
DEV int off128(int row, int ch) { return row * 128 + ((ch ^ ((row >> 1) & 7)) << 4); }
DEV int off256(int row, int ch) { return row * 256 + ((ch ^ (row & 15)) << 4); }
DEV f32x4 mfma16(bf16x8 a, bf16x8 b, f32x4 c) { return __builtin_amdgcn_mfma_f32_16x16x32_bf16(a, b, c, 0, 0, 0); }
DEV float wave_sum(float v) {
  v += __shfl_xor(v, 32); v += __shfl_xor(v, 16); v += __shfl_xor(v, 8); v += __shfl_xor(v, 4); v += __shfl_xor(v, 2); v += __shfl_xor(v, 1);
  return v;
}
#define VM_DRAIN() do { } while (0)
DEV int tidx() { int t = threadIdx.x; asm volatile("" : "+v"(t)); return t; }
DEV float silu_f(float v) { return v / (1.f + __expf(-v)); }
DEV void rope_sc(float pos, int f, float& sn, float& cs) {
  float invf = exp2f(-(float)f * 0.8304820237218406f);
  float rev = pos * invf * 0.15915494309189535f;
  rev = rev - floorf(rev);
  sn = __builtin_amdgcn_sinf(rev); cs = __builtin_amdgcn_cosf(rev);
}
#define rope_rot(A_, B_, POS_, F_) do { float sn_, cs_; rope_sc(POS_, F_, sn_, cs_); float a_ = (A_), b_ = (B_); (A_) = a_ * cs_ - b_ * sn_; (B_) = a_ * sn_ + b_ * cs_; } while (0)

DEV void tr_job(const float* __restrict__ src, int K, int N, u16* __restrict__ dst, const float* __restrict__ kscale, float scalar,
                int& rot, int vb, int G, float* tile) {
  const int tid = tidx();
  const int tn = N >> 6, tk = K >> 6, ntl = tn * tk;
  int start = (vb - (rot % G) + G) % G;
  for (int t = start; t < ntl; t += G) {
    int kb = t / tn, nb = t - kb * tn;
#pragma unroll
    for (int i = 0; i < 2; ++i) {
      int idx = tid + i * 512, r = idx >> 4, c4 = idx & 15;
      float4 v = *reinterpret_cast<const float4*>(src + (size_t)(kb * 64 + r) * N + nb * 64 + c4 * 4);
      float s = scalar * (kscale ? kscale[kb * 64 + r] : 1.f);
      float* tp = tile + r * 65 + c4 * 4;
      tp[0] = v.x * s; tp[1] = v.y * s; tp[2] = v.z * s; tp[3] = v.w * s;
    }
    __syncthreads();
    {
      int n = tid >> 3, k8 = (tid & 7) * 8;
      float e[8];
#pragma unroll
      for (int j = 0; j < 8; ++j) e[j] = tile[(k8 + j) * 65 + n];
      u32x4 w = {cvtpk(e[0], e[1]), cvtpk(e[2], e[3]), cvtpk(e[4], e[5]), cvtpk(e[6], e[7])};
      *reinterpret_cast<u32x4*>(dst + (size_t)(nb * 64 + n) * K + kb * 64 + k8) = w;
    }
    VM_DRAIN();
    __syncthreads();
  }
  rot += ntl;
}

DEV void phase0(const Params& p, int vb, int G, char* lds) {
  const int tid = tidx();
  u16* W = reinterpret_cast<u16*>(p.ws + WS_W);
  float* mod = reinterpret_cast<float*>(p.ws + WS_MOD);
  float* sc = reinterpret_cast<float*>(lds);
  float* red = sc + 5 * 1024;
  float* tile = red + 8 * 5 * 64;
  for (int idx = tid; idx < 5 * 1024; idx += NTHR) {
    int w = idx >> 10, k = idx & 1023;
    float v = (w < 4) ? p.c[w * 1024 + k] : p.c_ctx[k];
    sc[idx] = silu_f(v);
  }
  __syncthreads();
  for (int u = vb; u < 384; u += G) {
    int i = u / 96, n0 = (u - i * 96) * 64, cgi = tid & 63, kg = tid >> 6;
    float a0 = 0, a1 = 0, a2 = 0, a3 = 0, a4 = 0;
    const float* wp = p.ada_w + ((size_t)i * 1024 + kg * 128) * 6144 + n0 + cgi;
#pragma unroll 8
    for (int k = 0; k < 128; ++k) {
      float w = wp[(size_t)k * 6144];
      int kk = kg * 128 + k;
      a0 += sc[kk] * w; a1 += sc[1024 + kk] * w; a2 += sc[2048 + kk] * w; a3 += sc[3072 + kk] * w; a4 += sc[4096 + kk] * w;
    }
    red[(kg * 5 + 0) * 64 + cgi] = a0; red[(kg * 5 + 1) * 64 + cgi] = a1; red[(kg * 5 + 2) * 64 + cgi] = a2;
    red[(kg * 5 + 3) * 64 + cgi] = a3; red[(kg * 5 + 4) * 64 + cgi] = a4;
    __syncthreads();
    if (tid < 320) {
      int w5 = tid >> 6, cc = tid & 63;
      float s = p.ada_b[i * 6144 + n0 + cc];
#pragma unroll
      for (int g = 0; g < 8; ++g) s += red[(g * 5 + w5) * 64 + cc];
      mod[(size_t)(i * 5 + w5) * 6144 + n0 + cc] = s;
    }
    VM_DRAIN();
    __syncthreads();
  }
  int rot = 384;
  for (int j = 0; j < 2; ++j) {
    u16* wm = W + OFF_WMLA + j * SZ_MLA;
    tr_job(p.mla_w_dq + (size_t)j * 1024 * 384, 1024, 384, wm, nullptr, 1.f, rot, vb, G, tile);
    tr_job(p.mla_w_dkv + (size_t)j * 1024 * 320, 1024, 320, wm + 384 * 1024, nullptr, 1.f, rot, vb, G, tile);
    tr_job(p.mla_w_uq + (size_t)j * 384 * 1536, 384, 1536, wm + SZ_MLA_W1, p.mla_g_q + j * 384, 1.f, rot, vb, G, tile);
    tr_job(p.mla_w_ukv + (size_t)j * 256 * 2048, 256, 2048, wm + SZ_MLA_W1 + SZ_MLA_UQ, p.mla_g_kv + j * 256, 1.f, rot, vb, G, tile);
    tr_job(p.mla_w_o + (size_t)j * 1024 * 1024, 1024, 1024, wm + SZ_MLA_W1 + SZ_MLA_UQ + SZ_MLA_UKV, nullptr, 1.f, rot, vb, G, tile);
    u16* wg = W + OFF_WGLA + j * SZ_GLA;
    tr_job(p.gla_w_q + (size_t)j * 1024 * 512, 1024, 512, wg, nullptr, 0.08838834764831845f, rot, vb, G, tile);
    tr_job(p.gla_w_k + (size_t)j * 1024 * 512, 1024, 512, wg + 512 * 1024, nullptr, 1.f, rot, vb, G, tile);
    tr_job(p.gla_w_v + (size_t)j * 1024 * 1024, 1024, 1024, wg + 1024 * 1024, nullptr, 1.f, rot, vb, G, tile);
    tr_job(p.gla_w_r + (size_t)j * 1024 * 1024, 1024, 1024, wg + 2048 * 1024, nullptr, 1.f, rot, vb, G, tile);
    tr_job(p.gla_w_o + (size_t)j * 1024 * 1024, 1024, 1024, wg + SZ_GLA_W1, nullptr, 1.f, rot, vb, G, tile);
    for (int idx = vb * NTHR + tid; idx < 32768; idx += G * NTHR) {
      int dir = idx >> 14, r = (idx >> 10) & 15, k = idx & 1023;
      wg[(size_t)(3072 + dir * 16 + r) * 1024 + k] = f2bf(p.gla_w_gate1[(((size_t)j * 2 + dir) * 1024 + k) * 16 + r]);
    }
    for (int idx = vb * NTHR + tid; idx < 96 * 1024; idx += G * NTHR) wg[(size_t)3104 * 1024 + idx] = 0;
    for (int idx = vb * NTHR + tid; idx < 64 * 1024; idx += G * NTHR) wm[(size_t)704 * 1024 + idx] = 0;
    VM_DRAIN();
  }
  for (int i = 0; i < 4; ++i) {
    u16* wp = W + OFF_WMLP + i * SZ_MLP;
    tr_job(p.mlp_w1 + (size_t)i * 1024 * 4096, 1024, 4096, wp, nullptr, 1.f, rot, vb, G, tile);
    tr_job(p.mlp_w2 + (size_t)i * 4096 * 1024, 4096, 1024, wp + SZ_MLP1, nullptr, 1.f, rot, vb, G, tile);
  }
}

DEV void row_pass(const Params& p, int layer_add, int gate_idx, int gadd_idx,
                  int layer_norm, int sh_idx, int sc_idx, int gnorm_idx, bool first, bool last) {
  const int tid_ = tidx(); const int lane = tid_ & 63;
  const int gw = blockIdx.x * 8 + (tid_ >> 6), nw = gridDim.x * 8;
  const float* mod = reinterpret_cast<const float*>(p.ws + WS_MOD);
  float* xctx = reinterpret_cast<float*>(p.ws + WS_XCTX);
  u16* hbuf = reinterpret_cast<u16*>(p.ws + WS_H);
  const u16* ybuf = reinterpret_cast<const u16*>(p.ws + WS_Y);
  for (int m = gw; m < MROWS; m += nw) {
    int b = m / TT, t = m - b * TT;
    bool isctx = t < CTX;
    int w = isctx ? 4 : b;
    if (last && isctx) continue;
    float* xp = isctx ? xctx + (size_t)(b * CTX + t) * DM : p.out + ((size_t)b * SEQ + (t - CTX)) * DM;
    const float* xin = first ? (isctx ? p.ctx + (size_t)(b * CTX + t) * DM : p.x + ((size_t)b * SEQ + (t - CTX)) * DM) : xp;
    float4 xv[4];
#pragma unroll
    for (int q = 0; q < 4; ++q) { f32x4 t4 = __builtin_nontemporal_load(reinterpret_cast<const f32x4*>(xin + q * 256 + lane * 4)); xv[q] = float4{t4[0], t4[1], t4[2], t4[3]}; }
    if (layer_add >= 0) {
      const float* gate = mod + (size_t)((layer_add * 5 + w) * 6 + gate_idx) * 1024;
      const float* g = p.norm_g + (size_t)(layer_add * 4 + gadd_idx) * 1024;
      u32x2 yy[4]; float ys = 0;
#pragma unroll
      for (int q = 0; q < 4; ++q) {
        yy[q] = __builtin_nontemporal_load(reinterpret_cast<const u32x2*>(ybuf + (size_t)m * 1024 + q * 256 + lane * 4));
        float y0 = bflo(yy[q][0]), y1 = bfhi(yy[q][0]), y2 = bflo(yy[q][1]), y3 = bfhi(yy[q][1]);
        ys += y0 * y0 + y1 * y1 + y2 * y2 + y3 * y3;
      }
      ys = wave_sum(ys);
      const float r = rsqrtf(ys * (1.f / 1024.f) + EPS);
#pragma unroll
      for (int q = 0; q < 4; ++q) {
        int col = q * 256 + lane * 4;
        float4 gt = *reinterpret_cast<const float4*>(gate + col);
        float4 gg = *reinterpret_cast<const float4*>(g + col);
        xv[q].x += gt.x * (gg.x * (bflo(yy[q][0]) * r)); xv[q].y += gt.y * (gg.y * (bfhi(yy[q][0]) * r));
        xv[q].z += gt.z * (gg.z * (bflo(yy[q][1]) * r)); xv[q].w += gt.w * (gg.w * (bfhi(yy[q][1]) * r));
      }
    }
    if (layer_add >= 0 || first) {
#pragma unroll
      for (int q = 0; q < 4; ++q) *reinterpret_cast<float4*>(xp + q * 256 + lane * 4) = xv[q];
    }
    if (layer_norm >= 0) {
      float ss = 0;
#pragma unroll
      for (int q = 0; q < 4; ++q) ss += xv[q].x * xv[q].x + xv[q].y * xv[q].y + xv[q].z * xv[q].z + xv[q].w * xv[q].w;
      ss = wave_sum(ss);
      float r0 = rsqrtf(ss * (1.f / 1024.f) + EPS);
      const float* sh = mod + (size_t)((layer_norm * 5 + w) * 6 + sh_idx) * 1024;
      const float* scl = mod + (size_t)((layer_norm * 5 + w) * 6 + sc_idx) * 1024;
      const float* g = p.norm_g + (size_t)(layer_norm * 4 + gnorm_idx) * 1024;
#pragma unroll
      for (int q = 0; q < 4; ++q) {
        int col = q * 256 + lane * 4;
        float4 s4 = *reinterpret_cast<const float4*>(sh + col);
        float4 c4 = *reinterpret_cast<const float4*>(scl + col);
        float4 gg = *reinterpret_cast<const float4*>(g + col);
        float h0 = (xv[q].x * r0 * gg.x) * (1.f + c4.x) + s4.x, h1 = (xv[q].y * r0 * gg.y) * (1.f + c4.y) + s4.y;
        float h2 = (xv[q].z * r0 * gg.z) * (1.f + c4.z) + s4.z, h3 = (xv[q].w * r0 * gg.w) * (1.f + c4.w) + s4.w;
        u32x2 pk = {cvtpk(h0, h1), cvtpk(h2, h3)};
        *reinterpret_cast<u32x2*>(hbuf + (size_t)m * 1024 + col) = pk;
      }
    }
    VM_DRAIN();
  }
}

DEV u32x4 widen16(u32x2 x, u32x2 y) {
  auto r0 = __builtin_amdgcn_permlane16_swap(x[0], y[0], false, false);
  auto r1 = __builtin_amdgcn_permlane16_swap(x[1], y[1], false, false);
  return u32x4{r0[0], r1[0], r0[1], r1[1]};
}
struct Epi { u16* o0; u16* o1; u16* o2; float* f0; float* s0; float* s1; const float* r0; };
enum { E_Y = 0, E_MLP1 = 1, E_MLA1 = 2, E_MLAQ = 3, E_MLAKV = 4, E_GLA1 = 5 };

template <int EPI, int MT = 4>
DEV void gemm_phase(const u16* __restrict__ A, int lda, const u16* __restrict__ Bt, int K, int N, int rot, int vb, int G, char* lds, const Epi& e) {
  int tid = threadIdx.x; asm volatile("" : "+v"(tid)); const int lane = tid & 63, w = tid >> 6, wm = w >> 1, wn = w & 1, l15 = lane & 15, lq = lane >> 4;
  const int ntn = N >> 7, total = (MROWS / (64 * MT)) * ntn, nk = K >> 6;
  char* As = lds; char* Bs = lds + 98304;
  const int srow = tid >> 3, sch = tid & 7;
  if (__builtin_amdgcn_readfirstlane(w) >= 4) __builtin_amdgcn_s_setprio(1);
  int start = (vb - (rot % G) + G) % G;
  for (int t = start; t < total; t += G) {
    int mb = t / ntn, nb = t - mb * ntn;
    if (MT == 4 && ntn > 8 && (ntn & 7) == 0) {
      const int sidx = t >> 5, j5 = t & 31, scols = ntn >> 3, smb = sidx / scols, snb = sidx - smb * scols;
      mb = smb * 4 + (j5 >> 3); nb = snb * 8 + (j5 & 7);
    }
    const int m0 = mb * (64 * MT), n0 = nb * 128;
    f32x4 acc[4][MT];
    float zf_ = 0.f; asm volatile("" : "+v"(zf_));
#pragma unroll
    for (int i = 0; i < 4; ++i)
#pragma unroll
      for (int j = 0; j < MT; ++j) acc[i][j] = f32x4{zf_, zf_, zf_, zf_};
    auto stage = [&](int kt, int buf) {
#pragma unroll
      for (int i = 0; i < MT; ++i) { const int row = srow + i * 64;
        const u16* g = A + (size_t)(m0 + row) * lda + kt * 64 + ((sch ^ ((row >> 1) & 7)) << 3);
        __builtin_amdgcn_global_load_lds((const unsigned*)g, (unsigned*)(As + buf * 32768 + row * 128 + sch * 16), 16, 0, 0); }
#pragma unroll
      for (int i = 0; i < 2; ++i) { const int row = srow + i * 64;
        const u16* g = Bt + (size_t)(n0 + row) * K + kt * 64 + ((sch ^ ((row >> 1) & 7)) << 3);
        __builtin_amdgcn_global_load_lds((const unsigned*)g, (unsigned*)(Bs + buf * 16384 + row * 128 + sch * 16), 16, 0, 0); }
    };
    __syncthreads();
    if constexpr (EPI == E_MLAQ || EPI == E_MLAKV) {
      const int rrow = tid >> 1, hh = tid & 1, kh = K >> 1;
      const u16* ap = A + (size_t)(m0 + rrow) * lda + hh * kh;
      float ss = 0;
      for (int c = 0; c < kh; c += 8) {
        u32x4 v = *reinterpret_cast<const u32x4*>(ap + c);
#pragma unroll
        for (int z = 0; z < 4; ++z) { float lo = bflo(v[z]), hi2 = bfhi(v[z]); ss += lo * lo + hi2 * hi2; }
      }
      ss += __shfl_xor(ss, 1);
      if (hh == 0) reinterpret_cast<float*>(lds + 147456)[rrow] = rsqrtf(ss / (float)K + EPS);
    }
    asm volatile("s_waitcnt vmcnt(0) lgkmcnt(0)" ::: "memory");
    __syncthreads();
    stage(0, 0); stage(1, 1);
    int cb = 0, pb = 2;
    for (int kt = 0; kt < nk; ++kt) {
      if (kt + 1 < nk) asm volatile("s_waitcnt vmcnt(%0)" :: "n"(MT + 2) : "memory"); else asm volatile("s_waitcnt vmcnt(0)" ::: "memory");
      __builtin_amdgcn_s_barrier();
      __builtin_amdgcn_sched_barrier(0);
      const char* Ac = As + cb * 32768; const char* Bc = Bs + cb * 16384;
      bf16x8 bw[2][4], at[2][MT];
#pragma unroll
      for (int kk = 0; kk < 2; ++kk) {
        const int ch = kk * 4 + lq;
#pragma unroll
        for (int nt = 0; nt < 4; ++nt) bw[kk][nt] = *reinterpret_cast<const bf16x8*>(Bc + off128(wn * 64 + nt * 16 + l15, ch));
#pragma unroll
        for (int mt = 0; mt < MT; ++mt) at[kk][mt] = *reinterpret_cast<const bf16x8*>(Ac + off128(wm * (16 * MT) + mt * 16 + l15, ch));
      }
      __builtin_amdgcn_sched_barrier(0);
      if (kt + 2 < nk) stage(kt + 2, pb);
      __builtin_amdgcn_sched_barrier(0);
#pragma unroll
      for (int kk = 0; kk < 2; ++kk)
#pragma unroll
        for (int nt = 0; nt < 4; ++nt)
#pragma unroll
          for (int mt = 0; mt < MT; ++mt) acc[nt][mt] = mfma16(bw[kk][nt], at[kk][mt], acc[nt][mt]);
      cb = (cb == 2) ? 0 : cb + 1; pb = (pb == 2) ? 0 : pb + 1;
    }
    asm volatile("s_waitcnt lgkmcnt(0)" ::: "memory");
    __syncthreads();
    const int nw = n0 + wn * 64;
    const int mbase = m0 + wm * (16 * MT) + l15;
    const int nl = lq * 4;
    if constexpr (EPI == E_Y) {
#pragma unroll
      for (int mt = 0; mt < MT; ++mt) {
        const int m = mbase + mt * 16;
#pragma unroll
        for (int nt = 0; nt < 4; nt += 2) {
          f32x4 v = acc[nt][mt], v2 = acc[nt + 1][mt];
          u32x4 wv = widen16(u32x2{cvtpk(v[0], v[1]), cvtpk(v[2], v[3])}, u32x2{cvtpk(v2[0], v2[1]), cvtpk(v2[2], v2[3])});
          __builtin_nontemporal_store(wv, reinterpret_cast<u32x4*>(e.o0 + (size_t)m * 1024 + nw + (nt + (lq & 1)) * 16 + (lq & 2) * 4));
        }
      }
    } else if constexpr (EPI == E_MLP1) {
#pragma unroll
      for (int mt = 0; mt < MT; ++mt) {
        const int m = mbase + mt * 16;
#pragma unroll
        for (int nt = 0; nt < 4; nt += 2) {
          f32x4 v = acc[nt][mt], v2 = acc[nt + 1][mt];
#pragma unroll
          for (int j = 0; j < 4; ++j) { float r = fmaxf(v[j], 0.f); v[j] = r * r; float r2 = fmaxf(v2[j], 0.f); v2[j] = r2 * r2; }
          u32x4 wv = widen16(u32x2{cvtpk(v[0], v[1]), cvtpk(v[2], v[3])}, u32x2{cvtpk(v2[0], v2[1]), cvtpk(v2[2], v2[3])});
          __builtin_nontemporal_store(wv, reinterpret_cast<u32x4*>(e.o0 + (size_t)m * 4096 + nw + (nt + (lq & 1)) * 16 + (lq & 2) * 4));
        }
      }
    } else if constexpr (EPI == E_MLA1) {
      if (nw < 640) {
        const bool isq = nw < 384;
#pragma unroll
        for (int mt = 0; mt < MT; ++mt) {
          const int m = mbase + mt * 16;
#pragma unroll
          for (int nt = 0; nt < 4; nt += 2) {
            f32x4 v = acc[nt][mt], v2 = acc[nt + 1][mt];
            u32x4 wv = widen16(u32x2{cvtpk(v[0], v[1]), cvtpk(v[2], v[3])}, u32x2{cvtpk(v2[0], v2[1]), cvtpk(v2[2], v2[3])});
            if (isq) __builtin_nontemporal_store(wv, reinterpret_cast<u32x4*>(e.o0 + (size_t)m * 384 + nw + (nt + (lq & 1)) * 16 + (lq & 2) * 4));
            else     __builtin_nontemporal_store(wv, reinterpret_cast<u32x4*>(e.o1 + (size_t)m * 256 + (nw - 384) + (nt + (lq & 1)) * 16 + (lq & 2) * 4));
          }
        }
      } else if (nw == 640) {
#pragma unroll
        for (int mt = 0; mt < MT; ++mt) {
          const int m = mbase + mt * 16; const int tt = m % TT;
          if (tt >= CTX) {
            const int pos = tt - CTX; const float pr = (float)(pos >> 6), pc = (float)(pos & 63);
#pragma unroll
            for (int j = 0; j < 4; ++j) {
              rope_rot(acc[0][mt][j], acc[1][mt][j], pr, nl + j);
              rope_rot(acc[2][mt][j], acc[3][mt][j], pc, nl + j);
            }
          }
#pragma unroll
          for (int nt = 0; nt < 4; nt += 2) {
            f32x4 v = acc[nt][mt], v2 = acc[nt + 1][mt];
            u32x4 wv = widen16(u32x2{cvtpk(v[0], v[1]), cvtpk(v[2], v[3])}, u32x2{cvtpk(v2[0], v2[1]), cvtpk(v2[2], v2[3])});
            __builtin_nontemporal_store(wv, reinterpret_cast<u32x4*>(e.o2 + (size_t)m * 64 + (nt + (lq & 1)) * 16 + (lq & 2) * 4));
          }
        }
      }
    } else if constexpr (EPI == E_MLAQ) {
      const bool ropet = (nw % 192) == 128;
#pragma unroll
      for (int mt = 0; mt < MT; ++mt) {
        const int m = mbase + mt * 16; const int tt = m % TT;
        const float rs = reinterpret_cast<const float*>(lds + 147456)[wm * 64 + mt * 16 + l15];
#pragma unroll
        for (int nt = 0; nt < 4; ++nt) acc[nt][mt] = acc[nt][mt] * rs;
        if (ropet && tt >= CTX) {
          const int pos = tt - CTX; const float pr = (float)(pos >> 6), pc = (float)(pos & 63);
#pragma unroll
          for (int j = 0; j < 4; ++j) {
            rope_rot(acc[0][mt][j], acc[1][mt][j], pr, nl + j);
            rope_rot(acc[2][mt][j], acc[3][mt][j], pc, nl + j);
          }
        }
#pragma unroll
        for (int nt = 0; nt < 4; nt += 2) {
          f32x4 v = acc[nt][mt], v2 = acc[nt + 1][mt];
          u32x4 wv = widen16(u32x2{cvtpk(v[0], v[1]), cvtpk(v[2], v[3])}, u32x2{cvtpk(v2[0], v2[1]), cvtpk(v2[2], v2[3])});
          __builtin_nontemporal_store(wv, reinterpret_cast<u32x4*>(e.o0 + (size_t)m * 1536 + nw + (nt + (lq & 1)) * 16 + (lq & 2) * 4));
        }
      }
    } else if constexpr (EPI == E_MLAKV) {
#pragma unroll
      for (int mt = 0; mt < MT; ++mt) {
        const int m = mbase + mt * 16;
        const float rs = reinterpret_cast<const float*>(lds + 147456)[wm * 64 + mt * 16 + l15];
#pragma unroll
        for (int nt = 0; nt < 4; nt += 2) {
          f32x4 v = acc[nt][mt] * rs, v2 = acc[nt + 1][mt] * rs;
          u32x4 wv = widen16(u32x2{cvtpk(v[0], v[1]), cvtpk(v[2], v[3])}, u32x2{cvtpk(v2[0], v2[1]), cvtpk(v2[2], v2[3])});
          __builtin_nontemporal_store(wv, reinterpret_cast<u32x4*>(e.o0 + (size_t)m * 2048 + nw + (nt + (lq & 1)) * 16 + (lq & 2) * 4));
        }
      }
    } else if constexpr (EPI == E_GLA1) {
      if (nw < 3072) {
        u16* dst = e.o0 + (size_t)(nw >> 10) * ((size_t)MROWS * 1024);
        const int nc = nw & 1023; const bool dosilu = nw >= 2048;
#pragma unroll
        for (int mt = 0; mt < MT; ++mt) {
          const int m = mbase + mt * 16;
#pragma unroll
          for (int nt = 0; nt < 4; nt += 2) {
            f32x4 v = acc[nt][mt], v2 = acc[nt + 1][mt];
            if (dosilu) {
#pragma unroll
              for (int j = 0; j < 4; ++j) { v[j] = silu_f(v[j]); v2[j] = silu_f(v2[j]); }
            }
            u32x4 wv = widen16(u32x2{cvtpk(v[0], v[1]), cvtpk(v[2], v[3])}, u32x2{cvtpk(v2[0], v2[1]), cvtpk(v2[2], v2[3])});
            __builtin_nontemporal_store(wv, reinterpret_cast<u32x4*>(dst + (size_t)m * 1024 + nc + (nt + (lq & 1)) * 16 + (lq & 2) * 4));
          }
        }
      } else if (nw == 3072) {
#pragma unroll
        for (int mt = 0; mt < MT; ++mt) {
          const int m = mbase + mt * 16;
#pragma unroll
          for (int nt = 0; nt < 2; ++nt) *reinterpret_cast<f32x4*>(e.f0 + (size_t)m * 32 + nt * 16 + nl) = acc[nt][mt];
        }
      }
    }
    VM_DRAIN();
  }
  __builtin_amdgcn_s_setprio(0);
}

constexpr int KVBLK = 64;
constexpr float ATT_SCALE = 0.07216878364870322f;
constexpr float ATT_THR = 8.f;
constexpr int SHM_K = KVBLK * 192 * 2, SHM_V = KVBLK * 128 * 2;
#define KSWZ(row, colB) ((row) * 384 + ((colB) ^ ((((row) >> 1) & 7) << 4)))
#define SBAR() __builtin_amdgcn_sched_barrier(0)
DEV int crow(int r, int hi) { return (r & 3) + 8 * (r >> 2) + 4 * hi; }

DEV void partialSM(f32x16& p0, f32x16& p1, float& m_reg, float& mn, float& alpha) {
  constexpr float C = ATT_SCALE * 1.4426950408889634f;
  float pmax = p0[0];
#pragma unroll
  for (int r = 1; r < 16; ++r) pmax = fmaxf(pmax, p0[r]);
#pragma unroll
  for (int r = 0; r < 16; ++r) pmax = fmaxf(pmax, p1[r]);
  { auto rr = __builtin_amdgcn_permlane32_swap(__float_as_uint(pmax), __float_as_uint(pmax), false, false);
    pmax = fmaxf(__uint_as_float(rr[0]), __uint_as_float(rr[1])); }
  if (__builtin_expect(__all(pmax - m_reg <= ATT_THR / ATT_SCALE), 1)) { mn = m_reg; alpha = 1.f; }
  else { mn = fmaxf(m_reg, pmax); alpha = __builtin_amdgcn_exp2f((m_reg - mn) * C); m_reg = mn; }
  float mnC = -mn * C;
#pragma unroll
  for (int r = 0; r < 16; ++r) p0[r] = fmaf(p0[r], C, mnC);
#pragma unroll
  for (int r = 0; r < 16; ++r) p1[r] = fmaf(p1[r], C, mnC);
#pragma unroll
  for (int r = 0; r < 16; ++r) p0[r] = __builtin_amdgcn_exp2f(p0[r]);
}
DEV void finishSM(f32x16& p0, f32x16& p1, float alpha, float& l_reg, bf16x8& pa0, bf16x8& pa1, bf16x8& pa2, bf16x8& pa3) {
#pragma unroll
  for (int r = 0; r < 16; ++r) p1[r] = __builtin_amdgcn_exp2f(p1[r]);
  float ps = 0;
#pragma unroll
  for (int r = 0; r < 16; ++r) ps += p0[r];
#pragma unroll
  for (int r = 0; r < 16; ++r) ps += p1[r];
  { auto rr = __builtin_amdgcn_permlane32_swap(__float_as_uint(ps), __float_as_uint(ps), false, false);
    ps = __uint_as_float(rr[0]) + __uint_as_float(rr[1]); }
  l_reg = l_reg * alpha + ps;
#define PK4(P, BASE, OUT) do { unsigned a0 = cvtpk(P[BASE + 0], P[BASE + 1]), a1 = cvtpk(P[BASE + 2], P[BASE + 3]);   \
    unsigned b0 = cvtpk(P[BASE + 4], P[BASE + 5]), b1 = cvtpk(P[BASE + 6], P[BASE + 7]);                              \
    auto r0 = __builtin_amdgcn_permlane32_swap(a0, b0, false, false); auto r1 = __builtin_amdgcn_permlane32_swap(a1, b1, false, false); \
    u32x4 w = {r0[0], r1[0], r0[1], r1[1]}; OUT = *reinterpret_cast<bf16x8*>(&w); } while (0)
  PK4(p0, 0, pa0); PK4(p0, 8, pa1); PK4(p1, 0, pa2); PK4(p1, 8, pa3);
#undef PK4
}
DEV void qkt(f32x16& p0, f32x16& p1, const char* Ks, const bf16x8* qr, int r32, int hi) {
  { float zf = 0.f; asm volatile("" : "+v"(zf));
#pragma unroll
    for (int r = 0; r < 16; ++r) { p0[r] = zf; p1[r] = zf; } }
#pragma unroll
  for (int d0 = 0; d0 < 12; ++d0) { int cb = (d0 * 16 + hi * 8) * 2;
    bf16x8 b0 = *reinterpret_cast<const bf16x8*>(Ks + KSWZ(r32, cb));
    bf16x8 b1 = *reinterpret_cast<const bf16x8*>(Ks + KSWZ(32 + r32, cb));
    p0 = __builtin_amdgcn_mfma_f32_32x32x16_bf16(b0, qr[d0], p0, 0, 0, 0);
    p1 = __builtin_amdgcn_mfma_f32_32x32x16_bf16(b1, qr[d0], p1, 0, 0, 0); }
}
DEV int v_st(int k, int c) { const int kk = (k & ~0xC) | ((k & 4) << 1) | ((k & 8) >> 1); return ((kk >> 3) * 4 + (c >> 5)) * 512 + ((kk & 7) * 32 + (c & 31)) * 2; }
DEV int v_rd_base(int lane) { return ((lane & 3) << 3) | (((lane >> 2) & 3) << 6) | (((lane >> 4) & 1) << 5) | (((lane >> 5) & 1) << 8); }
constexpr int v_rd_off(int d0, int ks, int half) { return d0 * 512 + ks * 4096 + half * 2048; }
template <int OFF> DEV s16x4 tr_read(int vb) {
  s16x4 r; asm volatile("ds_read_b64_tr_b16 %0, %1 offset:%2" : "=&v"(r) : "v"(vb), "i"(OFF) : "memory"); return r;
}
template <int D0> DEV void pv_one(f32x16& od, int vb, bf16x8 pa0, bf16x8 pa1, bf16x8 pa2, bf16x8 pa3) {
  s16x4 l0, h0, l1, h1, l2, h2, l3, h3;
  asm volatile("ds_read_b64_tr_b16 %0, %8 offset:%9\n\t"
               "ds_read_b64_tr_b16 %1, %8 offset:%10\n\t"
               "ds_read_b64_tr_b16 %2, %8 offset:%11\n\t"
               "ds_read_b64_tr_b16 %3, %8 offset:%12\n\t"
               "ds_read_b64_tr_b16 %4, %8 offset:%13\n\t"
               "ds_read_b64_tr_b16 %5, %8 offset:%14\n\t"
               "ds_read_b64_tr_b16 %6, %8 offset:%15\n\t"
               "ds_read_b64_tr_b16 %7, %8 offset:%16\n\t"
               "s_waitcnt lgkmcnt(0)"
               : "=&v"(l0), "=&v"(h0), "=&v"(l1), "=&v"(h1), "=&v"(l2), "=&v"(h2), "=&v"(l3), "=&v"(h3)
               : "v"(vb), "i"(v_rd_off(D0, 0, 0)), "i"(v_rd_off(D0, 0, 1)), "i"(v_rd_off(D0, 1, 0)), "i"(v_rd_off(D0, 1, 1)),
                 "i"(v_rd_off(D0, 2, 0)), "i"(v_rd_off(D0, 2, 1)), "i"(v_rd_off(D0, 3, 0)), "i"(v_rd_off(D0, 3, 1))
               : "memory");
  SBAR();
#define PKV(L, H) (bf16x8){L[0], L[1], L[2], L[3], H[0], H[1], H[2], H[3]}
  od = __builtin_amdgcn_mfma_f32_32x32x16_bf16(pa0, PKV(l0, h0), od, 0, 0, 0);
  od = __builtin_amdgcn_mfma_f32_32x32x16_bf16(pa1, PKV(l1, h1), od, 0, 0, 0);
  od = __builtin_amdgcn_mfma_f32_32x32x16_bf16(pa2, PKV(l2, h2), od, 0, 0, 0);
  od = __builtin_amdgcn_mfma_f32_32x32x16_bf16(pa3, PKV(l3, h3), od, 0, 0, 0);
#undef PKV
}
DEV void pv_d0(f32x16* o, int vb, bf16x8 pa0, bf16x8 pa1, bf16x8 pa2, bf16x8 pa3) {
  pv_one<0>(o[0], vb, pa0, pa1, pa2, pa3); pv_one<1>(o[1], vb, pa0, pa1, pa2, pa3); pv_one<2>(o[2], vb, pa0, pa1, pa2, pa3); pv_one<3>(o[3], vb, pa0, pa1, pa2, pa3);
}

DEV void attn_body(const u16* __restrict__ Qb, const u16* __restrict__ Kn, const u16* __restrict__ Kr, const u16* __restrict__ Vh,
                   u16* __restrict__ Ob, int seq, char* lds) {
  int tid = threadIdx.x; asm volatile("" : "+v"(tid)); const int wid = tid >> 6, lane = tid & 63, r32 = lane & 31, hi = lane >> 5;
  char* V_lds = lds; char* K_lds = lds + 2 * SHM_V;
  float* wsl = reinterpret_cast<float*>(lds + 2 * SHM_V + 2 * SHM_K) + wid * 64; float* li_l = wsl; float* al_l = wsl + 32;
  asm volatile("s_waitcnt vmcnt(0) lgkmcnt(0)" ::: "memory");
  __syncthreads();
  float m_reg = -1e30f, l_reg = 0; f32x16 o[4] = {}; bf16x8 qr[12];
  const u16* Qw = Qb + (size_t)(wid * 32 + r32) * 1536 + hi * 8;
#pragma unroll
  for (int d0 = 0; d0 < 12; ++d0) qr[d0] = *reinterpret_cast<const bf16x8*>(Qw + d0 * 16);
  const int sr = tid >> 4, sc = (tid & 15) * 8, vst0 = v_st(sr, sc), vst1 = v_st(32 + sr, sc);
  const int rr_ = tid >> 3, rc_ = (tid & 7) * 8;
  const int vb0 = (int)(uintptr_t)V_lds + v_rd_base(lane);
  bf16x8 vs0, vs1, ks0, ks1, kr0;
#define SLOAD(k0) do { vs0 = *reinterpret_cast<const bf16x8*>(Vh + (size_t)((k0) + sr) * 2048 + sc); vs1 = *reinterpret_cast<const bf16x8*>(Vh + (size_t)((k0) + 32 + sr) * 2048 + sc); \
    ks0 = *reinterpret_cast<const bf16x8*>(Kn + (size_t)((k0) + sr) * 2048 + sc); ks1 = *reinterpret_cast<const bf16x8*>(Kn + (size_t)((k0) + 32 + sr) * 2048 + sc); \
    kr0 = *reinterpret_cast<const bf16x8*>(Kr + (size_t)((k0) + rr_) * 64 + rc_); } while (0)
#define SWRITE(b) do { *reinterpret_cast<bf16x8*>(V_lds + (b) * SHM_V + vst0) = vs0; *reinterpret_cast<bf16x8*>(V_lds + (b) * SHM_V + vst1) = vs1; \
    *reinterpret_cast<bf16x8*>(K_lds + (b) * SHM_K + KSWZ(sr, sc * 2)) = ks0; *reinterpret_cast<bf16x8*>(K_lds + (b) * SHM_K + KSWZ(32 + sr, sc * 2)) = ks1; \
    *reinterpret_cast<bf16x8*>(K_lds + (b) * SHM_K + KSWZ(rr_, 256 + rc_ * 2)) = kr0; } while (0)
#define SWAIT() asm volatile("s_waitcnt vmcnt(0)" ::: "memory")
#define RESC(a) do { if (__any((a) < 1.f)) { if (hi == 0) al_l[r32] = (a); asm volatile("s_waitcnt lgkmcnt(0)" ::: "memory"); \
    _Pragma("unroll") for (int d = 0; d < 4; ++d) _Pragma("unroll") for (int r = 0; r < 16; ++r) o[d][r] *= al_l[crow(r, hi)]; } } while (0)
  f32x16 pA0, pA1; float mnA, alA; bf16x8 pa0, pa1, pa2, pa3; const int NTL = seq / KVBLK;
  SLOAD(0); SWAIT(); SWRITE(0); __syncthreads();
  for (int j = 0; j < NTL; ++j) {
    const int cur = j & 1;
    if (j + 1 < NTL) SLOAD((j + 1) * KVBLK);
    SBAR(); qkt(pA0, pA1, K_lds + cur * SHM_K, qr, r32, hi);
    partialSM(pA0, pA1, m_reg, mnA, alA);
    RESC(alA);
    finishSM(pA0, pA1, alA, l_reg, pa0, pa1, pa2, pa3); SBAR();
    pv_d0(o, vb0 + cur * SHM_V, pa0, pa1, pa2, pa3);
    if (j + 1 < NTL) { SWAIT(); SWRITE(cur ^ 1); }
    __syncthreads();
  }
  if (hi == 0) li_l[r32] = l_reg; asm volatile("s_waitcnt lgkmcnt(0)" ::: "memory");
  u16* Ow = Ob + (size_t)(wid * 32) * 1024;
  unsigned voff = hi * 4096 + r32;
  asm volatile("" : "+v"(voff));
#pragma unroll
  for (int r = 0; r < 16; ++r) { const int cr = (r & 3) + 8 * (r >> 2); float rl = __builtin_amdgcn_rcpf(li_l[cr + 4 * hi]);
    u16* rowp = Ow + cr * 1024;
#pragma unroll
    for (int d0 = 0; d0 < 4; ++d0) rowp[voff + d0 * 32] = f2bf(o[d0][r] * rl); }
  asm volatile("s_waitcnt vmcnt(0) lgkmcnt(0)" ::: "memory");
  __syncthreads();
#undef SLOAD
#undef SWRITE
#undef SWAIT
#undef RESC
}

DEV void attn_phase(const Params& p, bool need_ctx, int vb, int G, char* lds) {
  const u16* q = reinterpret_cast<const u16*>(p.ws + WS_R);
  const u16* kv = q + (size_t)MROWS * 1536;
  const u16* krope = reinterpret_cast<const u16*>(p.ws + WS_Y) + (size_t)MROWS * (384 + 256);
  u16* ob = reinterpret_cast<u16*>(p.ws + WS_H);
  const int nitems = 1024 + (need_ctx ? 32 : 0);
  if (__builtin_amdgcn_readfirstlane((int)(threadIdx.x >> 6)) >= 4) __builtin_amdgcn_s_setprio(1);
  for (int it = vb; it < nitems; it += G) {
    int bh, qrow0, seq;
    if (it < 1024) { bh = it >> 5; qrow0 = CTX + (it & 31) * 256; seq = TT; }
    else { bh = it - 1024; qrow0 = 0; seq = CTX; }
    const int b = bh >> 3, h = bh & 7;
    const size_t r0 = (size_t)b * TT;
    attn_body(q + (r0 + qrow0) * 1536 + h * 192, kv + r0 * 2048 + h * 256, krope + r0 * 64, kv + r0 * 2048 + h * 256 + 128,
              ob + (r0 + qrow0) * 1024 + h * 128, seq, lds);
  }
  __builtin_amdgcn_s_setprio(0);
}

DEV void gla_scan(const Params& p, int lj, int vb, int G, char* lds) {
  int tid = threadIdx.x; asm volatile("" : "+v"(tid)); const int lane = tid & 63, w = tid >> 6, l15 = lane & 15, lq = lane >> 4;
  const u16* qk = reinterpret_cast<const u16*>(p.ws + WS_R);
  const u16* vbuf = qk + (size_t)MROWS * 1024;
  const float* gl = reinterpret_cast<const float*>(p.ws + WS_R + (size_t)MROWS * 1024 * 2 * 3);
  u16* rawQ = reinterpret_cast<u16*>(lds); u16* rawK = reinterpret_cast<u16*>(lds + 16384); u16* rawV = reinterpret_cast<u16*>(lds + 32768);
  float* glS = reinterpret_cast<float*>(lds + 36864);
  char* qt = lds + 40960; char* kt = lds + 57344; char* kendT = lds + 73728; char* vT = lds + 90112; char* Ab = lds + 94208; char* ST = lds + 102400;
  float* decS = reinterpret_cast<float*>(lds + 110592); float* gsum = reinterpret_cast<float*>(lds + 111104);
  const int d = tid & 127, ig = tid >> 7;
  for (int u = vb; u < 256; u += G) {
    const int s = u & 7, dir = (u >> 3) & 1, h = (u >> 4) & 3, b = u >> 6;
    u16* odir = reinterpret_cast<u16*>(p.ws + (dir == 0 ? WS_H : WS_Y));
    const int dg = w * 16 + l15;
    bf16x8 w2f;
    { float wv_[8];
#pragma unroll
      for (int jj = 0; jj < 8; ++jj) { const int r = (lq & 1) * 8 + jj;
        const float v = p.gla_w_gate2[((size_t)(lj * 2 + dir) * 16 + r) * 512 + h * 128 + dg]; wv_[jj] = (lq < 2) ? v : 0.f; }
      u32x4 wv4 = {cvtpk(wv_[0], wv_[1]), cvtpk(wv_[2], wv_[3]), cvtpk(wv_[4], wv_[5]), cvtpk(wv_[6], wv_[7])};
      w2f = *reinterpret_cast<bf16x8*>(&wv4); }
    const float bias = p.gla_b_gate[(size_t)(lj * 2 + dir) * 512 + h * 128 + dg];
    f32x4 Sacc[2] = {f32x4{0, 0, 0, 0}, f32x4{0, 0, 0, 0}};
    __syncthreads();
    *reinterpret_cast<u32x4*>(ST + tid * 16) = u32x4{0, 0, 0, 0};
    bf16x8 pq[2], pk[2]; u32x4 pv;
    auto rowof = [&](int n, int i) -> size_t { int pp = n * 64 + i; int t = (dir == 0) ? pp : (pp < CTX ? (CTX - 1 - pp) : (TT + CTX - 1 - pp)); return (size_t)b * TT + t; };
    auto gload = [&](int n) {
#pragma unroll
      for (int x = 0; x < 2; ++x) { int c = tid + x * 512, i = c >> 4, ch = c & 15; size_t row = rowof(n, i);
        pq[x] = *reinterpret_cast<const bf16x8*>(qk + row * 1024 + h * 128 + ch * 8);
        pk[x] = *reinterpret_cast<const bf16x8*>(qk + row * 1024 + 512 + h * 128 + ch * 8); }
      if (tid < 256) { int i = tid >> 2, ch = tid & 3; pv = *reinterpret_cast<const u32x4*>(vbuf + rowof(n, i) * 1024 + h * 256 + s * 32 + ch * 8); }
      else { int i = (tid - 256) >> 2, ch = tid & 3; pv = *reinterpret_cast<const u32x4*>(gl + rowof(n, i) * 32 + dir * 16 + ch * 4); }
    };
    auto lstore = [&]() {
#pragma unroll
      for (int x = 0; x < 2; ++x) { int c = tid + x * 512, i = c >> 4, ch = c & 15;
        *reinterpret_cast<bf16x8*>(rawQ + i * 128 + ch * 8) = pq[x]; *reinterpret_cast<bf16x8*>(rawK + i * 128 + ch * 8) = pk[x]; }
      if (tid < 256) { int i = tid >> 2, ch = tid & 3; *reinterpret_cast<u32x4*>(rawV + i * 32 + ch * 8) = pv; }
      else { int i = (tid - 256) >> 2, ch = tid & 3; *reinterpret_cast<u32x4*>(glS + i * 16 + ch * 4) = pv; }
    };
    gload(0); lstore();
    const int it = w >> 1, wv = w & 1;
    for (int n = 0; n < 132; ++n) {
      VM_DRAIN();
      __syncthreads();
      if (n + 1 < 132) gload(n + 1);
      float gq[4][4];
#pragma unroll
      for (int tt = 0; tt < 4; ++tt) {
        const float* gp = glS + (tt * 16 + l15) * 16 + (lq & 1) * 8;
        f32x4 g0 = *reinterpret_cast<const f32x4*>(gp), g1 = *reinterpret_cast<const f32x4*>(gp + 4);
        if (lq >= 2) { g0 = f32x4{0, 0, 0, 0}; g1 = f32x4{0, 0, 0, 0}; }
        u32x4 ga = {cvtpk(g0[0], g0[1]), cvtpk(g0[2], g0[3]), cvtpk(g1[0], g1[1]), cvtpk(g1[2], g1[3])};
        f32x4 xa = mfma16(*reinterpret_cast<bf16x8*>(&ga), w2f, f32x4{0, 0, 0, 0});
#pragma unroll
        for (int j = 0; j < 4; ++j) { const float xg = xa[j] + bias;
          gq[tt][j] = (fminf(xg, 0.f) - __logf(1.f + __expf(-fabsf(xg)))) * (1.f / 16.f); }
      }
      float base = 0.f, tot = 0.f;
#pragma unroll
      for (int tt = 0; tt < 4; ++tt) {
        gq[tt][1] += gq[tt][0]; gq[tt][2] += gq[tt][1]; gq[tt][3] += gq[tt][2];
        const float T = gq[tt][3];
        const float u1 = __shfl(T, (lane - 16) & 63), u2 = __shfl(T, (lane - 32) & 63), u3 = __shfl(T, (lane - 48) & 63);
        const float E = (lq >= 1 ? u1 : 0.f) + (lq >= 2 ? u2 : 0.f) + (lq >= 3 ? u3 : 0.f);
        float S = T + __shfl_xor(T, 16); S += __shfl_xor(S, 32);
#pragma unroll
        for (int j = 0; j < 4; ++j) gq[tt][j] += base + E;
        base += S;
      }
      tot = base;
      if (lq == 0) decS[dg] = __expf(tot);
#pragma unroll
      for (int tt = 0; tt < 4; ++tt) {
        float ke[4];
#pragma unroll
        for (int j = 0; j < 4; ++j) {
          const int i = tt * 16 + lq * 4 + j; const float Gv = gq[tt][j];
          const float qv = bf2f(rawQ[i * 128 + dg]), kvv = bf2f(rawK[i * 128 + dg]);
          *reinterpret_cast<u16*>(qt + off256(i, dg >> 3) + (dg & 7) * 2) = f2bf(qv * __expf(Gv));
          *reinterpret_cast<u16*>(kt + off256(i, dg >> 3) + (dg & 7) * 2) = f2bf(kvv * __expf(-Gv));
          ke[j] = kvv * __expf(tot - Gv);
        }
        *reinterpret_cast<u32x2*>(kendT + off128(dg, tt * 2 + (lq >> 1)) + (lq & 1) * 8) = u32x2{cvtpk(ke[0], ke[1]), cvtpk(ke[2], ke[3])};
      }
      { const int vc = tid & 31, jg = tid >> 5;
        unsigned a0 = rawV[(jg * 4 + 0) * 32 + vc], a1 = rawV[(jg * 4 + 1) * 32 + vc], a2 = rawV[(jg * 4 + 2) * 32 + vc], a3 = rawV[(jg * 4 + 3) * 32 + vc];
        *reinterpret_cast<u32x2*>(vT + off128(vc, jg >> 1) + (jg & 1) * 8) = u32x2{a0 | (a1 << 16), a2 | (a3 << 16)}; }
      __syncthreads();
      if (n + 1 < 132) lstore();
      f32x4 oacc = f32x4{0, 0, 0, 0};
      bf16x8 qa[4];
#pragma unroll
      for (int ks = 0; ks < 4; ++ks) qa[ks] = *reinterpret_cast<const bf16x8*>(qt + off256(it * 16 + l15, ks * 4 + lq));
#pragma unroll
      for (int ks = 0; ks < 4; ++ks) { bf16x8 bb = *reinterpret_cast<const bf16x8*>(ST + off256(wv * 16 + l15, ks * 4 + lq)); oacc = mfma16(qa[ks], bb, oacc); }
#pragma unroll
      for (int x = 0; x < 2; ++x) {
        const int jt = wv * 2 + x; f32x4 aacc = f32x4{0, 0, 0, 0};
        if (jt <= it) {
#pragma unroll
          for (int ks = 0; ks < 4; ++ks) { bf16x8 bb = *reinterpret_cast<const bf16x8*>(kt + off256(jt * 16 + l15, ks * 4 + lq)); aacc = mfma16(qa[ks], bb, aacc); }
        }
#pragma unroll
        for (int jj = 0; jj < 4; ++jj) { const int i = it * 16 + lq * 4 + jj, j = jt * 16 + l15;
          *reinterpret_cast<u16*>(Ab + off128(i, j >> 3) + (j & 7) * 2) = f2bf(j <= i ? aacc[jj] : 0.f); }
      }
      __syncthreads();
#pragma unroll
      for (int ks = 0; ks < 2; ++ks) { bf16x8 a = *reinterpret_cast<const bf16x8*>(Ab + off128(it * 16 + l15, ks * 4 + lq));
        bf16x8 bb = *reinterpret_cast<const bf16x8*>(vT + off128(wv * 16 + l15, ks * 4 + lq)); oacc = mfma16(a, bb, oacc); }
#pragma unroll
      for (int jj = 0; jj < 4; ++jj) { const int i = it * 16 + lq * 4 + jj;
        odir[rowof(n, i) * 1024 + h * 256 + s * 32 + wv * 16 + l15] = f2bf(oacc[jj]); }
      f32x4 dv = *reinterpret_cast<const f32x4*>(decS + w * 16 + lq * 4);
      bf16x8 ka[2];
#pragma unroll
      for (int ks = 0; ks < 2; ++ks) ka[ks] = *reinterpret_cast<const bf16x8*>(kendT + off128(w * 16 + l15, ks * 4 + lq));
#pragma unroll
      for (int vt = 0; vt < 2; ++vt) {
        Sacc[vt] = Sacc[vt] * dv;
#pragma unroll
        for (int ks = 0; ks < 2; ++ks) { bf16x8 bb = *reinterpret_cast<const bf16x8*>(vT + off128(vt * 16 + l15, ks * 4 + lq)); Sacc[vt] = mfma16(ka[ks], bb, Sacc[vt]); }
        *reinterpret_cast<u32x2*>(ST + off256(vt * 16 + l15, w * 2 + (lq >> 1)) + (lq & 1) * 8) = u32x2{cvtpk(Sacc[vt][0], Sacc[vt][1]), cvtpk(Sacc[vt][2], Sacc[vt][3])};
      }
    }
  }
}

DEV void gla_out_pass(const Params& p, int lj) {
  const int tid_ = tidx(); const int lane = tid_ & 63;
  const int gw = blockIdx.x * 8 + (tid_ >> 6), nw = gridDim.x * 8;
  u16* of = reinterpret_cast<u16*>(p.ws + WS_H);
  const u16* ob = reinterpret_cast<const u16*>(p.ws + WS_Y);
  const u16* rb = reinterpret_cast<const u16*>(p.ws + WS_R) + (size_t)MROWS * 2048;
  float go[16];
#pragma unroll
  for (int j = 0; j < 4; ++j) { float4 g4 = *reinterpret_cast<const float4*>(p.gla_g_o + lj * 256 + (lane & 15) * 16 + j * 4); go[j * 4] = g4.x; go[j * 4 + 1] = g4.y; go[j * 4 + 2] = g4.z; go[j * 4 + 3] = g4.w; }
  for (int m = gw; m < MROWS; m += nw) {
    const size_t base = (size_t)m * 1024 + lane * 16;
    u32x4 f0 = *reinterpret_cast<const u32x4*>(of + base), f1 = *reinterpret_cast<const u32x4*>(of + base + 8);
    u32x4 b0 = *reinterpret_cast<const u32x4*>(ob + base), b1 = *reinterpret_cast<const u32x4*>(ob + base + 8);
    u32x4 r0 = *reinterpret_cast<const u32x4*>(rb + base), r1 = *reinterpret_cast<const u32x4*>(rb + base + 8);
    float o[16], rr[16];
#pragma unroll
    for (int j = 0; j < 4; ++j) {
      o[2 * j] = bflo(f0[j]) + bflo(b0[j]); o[2 * j + 1] = bfhi(f0[j]) + bfhi(b0[j]);
      o[8 + 2 * j] = bflo(f1[j]) + bflo(b1[j]); o[8 + 2 * j + 1] = bfhi(f1[j]) + bfhi(b1[j]);
      rr[2 * j] = bflo(r0[j]); rr[2 * j + 1] = bfhi(r0[j]); rr[8 + 2 * j] = bflo(r1[j]); rr[8 + 2 * j + 1] = bfhi(r1[j]);
    }
    float ss = 0;
#pragma unroll
    for (int j = 0; j < 16; ++j) ss += o[j] * o[j];
    ss += __shfl_xor(ss, 8); ss += __shfl_xor(ss, 4); ss += __shfl_xor(ss, 2); ss += __shfl_xor(ss, 1);
    const float rs = rsqrtf(ss * (1.f / 256.f) + EPS);
    float y[16];
#pragma unroll
    for (int j = 0; j < 16; ++j) y[j] = (o[j] * rs * go[j]) * rr[j];
    u32x4 w0 = {cvtpk(y[0], y[1]), cvtpk(y[2], y[3]), cvtpk(y[4], y[5]), cvtpk(y[6], y[7])};
    u32x4 w1 = {cvtpk(y[8], y[9]), cvtpk(y[10], y[11]), cvtpk(y[12], y[13]), cvtpk(y[14], y[15])};
    *reinterpret_cast<u32x4*>(of + base) = w0; *reinterpret_cast<u32x4*>(of + base + 8) = w1;
    VM_DRAIN();
  }
}

#define XB_TMO      128
#define XB_XCNT(j)  (256  + 64 * (j))
#define XB_XSUB(j)  (1280 + 64 * (j))
#define XB_XGEN(j)  (2304 + 64 * (j))
#define XB_TOP      3328
#define XB_TOPGEN   3392
#define XCD_BAR_WORDS 3456
#define XB_SPIN_CAP (1u << 18)
#define LAS __attribute__((address_space(3)))

__device__ __forceinline__ unsigned xb_ld(unsigned* p)              { return __hip_atomic_load(p, __ATOMIC_RELAXED, __HIP_MEMORY_SCOPE_AGENT); }
__device__ __forceinline__ unsigned xb_add(unsigned* p, unsigned v) { return __hip_atomic_fetch_add(p, v, __ATOMIC_RELAXED, __HIP_MEMORY_SCOPE_AGENT); }
__device__ __forceinline__ unsigned xb_xcc_id() { return (unsigned)__builtin_amdgcn_s_getreg((3 << 11) | 20) & 0xFu; }
#define XB_SPIN(cond, bar) do { unsigned _sp = 0; while (cond) { __builtin_amdgcn_s_sleep(1); \
    if ((++_sp & 255u) == 0u) { if (xb_ld(&(bar)[XB_TMO])) break; if (_sp > XB_SPIN_CAP) { atomicAdd(&(bar)[XB_TMO], 1u); break; } } } } while (0)

struct XcdBarrier {
    unsigned* bar; unsigned x;
    volatile LAS unsigned* st;
};

__device__ __forceinline__ XcdBarrier xcd_barrier_post(unsigned* bar, volatile LAS unsigned* st) {
    XcdBarrier b; b.bar = bar; b.x = xb_xcc_id(); b.st = st;
    if (threadIdx.x == 0) (void)xb_add(&bar[XB_XCNT(b.x)], 1u);
    return b;
}
__device__ __forceinline__ void xcd_barrier_complete(unsigned* bar, unsigned x, unsigned& nloc, unsigned& nx) {
    const unsigned G = gridDim.x * gridDim.y * gridDim.z;
    unsigned sum, cnt, mine, sp = 0u;
    for (;;) {
        sum = 0u; cnt = 0u; mine = 0u;
#pragma unroll
        for (unsigned j = 0; j < 16; ++j) { const unsigned c = xb_ld(&bar[XB_XCNT(j)]); sum += c; cnt += (c > 0u) ? 1u : 0u; mine = (j == x) ? c : mine; }
        if (sum == G) break;
        __builtin_amdgcn_s_sleep(1);
        if ((++sp & 255u) == 0u) { if (xb_ld(&bar[XB_TMO])) break; if (sp > XB_SPIN_CAP) { atomicAdd(&bar[XB_TMO], 1u); break; } }
    }
    nloc = mine > 0u ? mine : 1u; nx = cnt > 0u ? cnt : 1u;
}

__device__ __forceinline__ void xcd_barrier(const XcdBarrier& b) {
    asm volatile("s_waitcnt vmcnt(0)" ::: "memory");
    __syncthreads();
    if (threadIdx.x == 0) {
        unsigned* bar = b.bar;
        __builtin_amdgcn_s_waitcnt(0);
        unsigned nloc = b.st[0], nx = b.st[1];
        if (nloc == 0u) { xcd_barrier_complete(bar, b.x, nloc, nx); b.st[0] = nloc; b.st[1] = nx; }
        const unsigned old = xb_add(&bar[XB_XSUB(b.x)], 1u);
        const unsigned gen = old / nloc;
        if (old + 1u == (gen + 1u) * nloc) {
            __builtin_amdgcn_fence(__ATOMIC_RELEASE, "agent");
            asm volatile("s_waitcnt vmcnt(0)" ::: "memory");
            const unsigned og = xb_add(&bar[XB_TOP], 1u);
            const unsigned tg = og / nx;
            if (og + 1u == (tg + 1u) * nx) xb_add(&bar[XB_TOPGEN], 1u);
            else XB_SPIN(xb_ld(&bar[XB_TOPGEN]) == tg, bar);
            __builtin_amdgcn_fence(__ATOMIC_ACQUIRE, "agent");
            xb_add(&bar[XB_XGEN(b.x)], 1u);
            asm volatile("s_waitcnt vmcnt(0)" ::: "memory");
        } else {
            XB_SPIN(xb_ld(&bar[XB_XGEN(b.x)]) == gen, bar);
            __builtin_amdgcn_fence(__ATOMIC_ACQUIRE, "agent");
            asm volatile("s_waitcnt vmcnt(0)" ::: "memory");
        }
    }
    __syncthreads();
}

__global__ void __launch_bounds__(NTHR) mega(Params p, int ph_lo, int ph_hi) {
  extern __shared__ __attribute__((aligned(16))) char lds[];
  cg::grid_group grid = cg::this_grid();
#define GSYNC() do { asm volatile("s_waitcnt vmcnt(0) lgkmcnt(0)" ::: "memory"); __syncthreads(); grid.sync(); __builtin_amdgcn_fence(__ATOMIC_ACQUIRE, "agent"); asm volatile("s_waitcnt vmcnt(0) lgkmcnt(0)" ::: "memory"); __syncthreads(); } while (0)
  const int G = gridDim.x;
  unsigned* bar = reinterpret_cast<unsigned*>(p.ws + WS_STAT);
  volatile LAS unsigned* xst = (volatile LAS unsigned*)(LAS char*)(lds + 149504);
  if (threadIdx.x == 0) { xst[0] = 0u; xst[1] = 0u; }
  __syncthreads();
  XcdBarrier xbar = xcd_barrier_post(bar, xst);
  const int vb = ((G & 7) == 0) ? (int)((blockIdx.x & 7) * (G >> 3) + (blockIdx.x >> 3)) : (int)blockIdx.x;
#define W_ reinterpret_cast<u16*>(p.ws + WS_W)
#define hbuf reinterpret_cast<u16*>(p.ws + WS_H)
#define ybuf reinterpret_cast<u16*>(p.ws + WS_Y)
#define rbuf reinterpret_cast<u16*>(p.ws + WS_R)
#define wmlp (W_ + OFF_WMLP + (size_t)layer * SZ_MLP)
#define wm (W_ + OFF_WMLA + (size_t)j * SZ_MLA)
#define wg (W_ + OFF_WGLA + (size_t)j * SZ_GLA)
#define cq ybuf
#define ckv (ybuf + (size_t)MROWS * 384)
#define krope (ybuf + (size_t)MROWS * 640)
#define qb rbuf
#define kvb (rbuf + (size_t)MROWS * 1536)
#pragma unroll 1
  for (int ph = ph_lo; ph < ph_hi; ++ph) {
    if (ph == 0) {
      phase0(p, vb, G, lds);
    } else if (ph == 33) {
      row_pass(p, 3, 5, 3, -1, 0, 0, 0, false, true);
    } else {
      const int layer = (ph - 1) >> 3, sub = (ph - 1) & 7, j = layer >> 1;
      const bool mla = (layer & 1) == 0;
      if (sub == 0) {
        row_pass(p, layer > 0 ? layer - 1 : -1, 5, 3, layer, 0, 1, 0, layer == 0, false);
      } else if (sub == 1) {
        if (mla) { Epi e{cq, ckv, krope, nullptr, nullptr, nullptr, nullptr};
          gemm_phase<E_MLA1>(hbuf, 1024, wm, 1024, 768, 0, vb, G, lds, e); }
        else { Epi e{rbuf, rbuf + (size_t)MROWS * 1024, rbuf + (size_t)MROWS * 2048, reinterpret_cast<float*>(rbuf + (size_t)MROWS * 3072), nullptr, nullptr, nullptr};
          gemm_phase<E_GLA1>(hbuf, 1024, wg, 1024, 3200, 0, vb, G, lds, e); }
      } else if (sub == 2) {
        if (mla) {
          { Epi e{qb, nullptr, nullptr, nullptr, nullptr, nullptr, nullptr};
            gemm_phase<E_MLAQ>(cq, 384, wm + SZ_MLA_W1, 384, 1536, 0, vb, G, lds, e); }
          { Epi e{kvb, nullptr, nullptr, nullptr, nullptr, nullptr, nullptr};
            gemm_phase<E_MLAKV>(ckv, 256, wm + SZ_MLA_W1 + SZ_MLA_UQ, 256, 2048, 132 * 12, vb, G, lds, e); }
        } else {
          gla_scan(p, j, vb, G, lds);
        }
      } else if (sub == 3) {
        if (mla) attn_phase(p, layer < 3, vb, G, lds);
        else gla_out_pass(p, j);
      } else if (sub == 4) {
        Epi e{ybuf, nullptr, nullptr, nullptr, nullptr, nullptr, nullptr};
        gemm_phase<E_Y, 3>(hbuf, 1024, mla ? wm + SZ_MLA_W1 + SZ_MLA_UQ + SZ_MLA_UKV : wg + SZ_GLA_W1, 1024, 1024, 0, vb, G, lds, e);
      } else if (sub == 5) {
        row_pass(p, layer, 2, 1, layer, 3, 4, 2, false, false);
      } else if (sub == 6) {
        Epi e{rbuf, nullptr, nullptr, nullptr, nullptr, nullptr, nullptr};
        gemm_phase<E_MLP1>(hbuf, 1024, wmlp, 1024, 4096, 0, vb, G, lds, e);
      } else {
        Epi e{ybuf, nullptr, nullptr, nullptr, nullptr, nullptr, nullptr};
        gemm_phase<E_Y, 3>(rbuf, 4096, wmlp + SZ_MLP1, 4096, 1024, 0, vb, G, lds, e);
      }
    }
    if (ph + 1 < ph_hi) {
      if (ph_hi < 0) { GSYNC(); }
      {
        asm volatile("s_waitcnt vmcnt(0) lgkmcnt(0)" ::: "memory");
        xcd_barrier(xbar);
      }
    }
  }
}

#undef W_
#undef hbuf
#undef ybuf
#undef rbuf
#undef wmlp
#undef wm
#undef wg
#undef cq
#undef ckv
#undef krope
#undef qb
#undef kvb
#ifndef N_SPLIT
#define N_SPLIT 1
#endif
extern "C" void kernel_launch(void* const* d_in, const int* in_sizes, int n_in, void* d_out, int out_size, void* d_ws, size_t ws_size, hipStream_t stream) {
  static int grid_blocks = 0;
  if (grid_blocks == 0) {
    if (n_in != 25 || ws_size < WS_END) { fprintf(stderr, "kernel_launch: bad inputs n_in %d ws %zu need %zu\n", n_in, ws_size, (size_t)WS_END); grid_blocks = -1; return; }
    int dev = 0, cus = 0, per_cu = 0;
    (void)hipGetDevice(&dev);
    (void)hipDeviceGetAttribute(&cus, hipDeviceAttributeMultiprocessorCount, dev);
    if (hipFuncSetAttribute((const void*)mega, hipFuncAttributeMaxDynamicSharedMemorySize, LDS_BYTES) != hipSuccess) { fprintf(stderr, "kernel_launch: set LDS attr failed\n"); grid_blocks = -1; return; }
    if (hipOccupancyMaxActiveBlocksPerMultiprocessor(&per_cu, (const void*)mega, NTHR, LDS_BYTES) != hipSuccess || per_cu < 1) { fprintf(stderr, "kernel_launch: occupancy query failed (%d)\n", per_cu); per_cu = 1; }
    (void)hipGetLastError();
    grid_blocks = cus;
  }
  if (grid_blocks < 0) return;
  Params p{};
  const float** pf = reinterpret_cast<const float**>(&p);
  for (int i = 0; i < 25; ++i) pf[i] = (const float*)d_in[i];
  p.out = (float*)d_out; p.ws = (unsigned char*)d_ws;
#ifdef SEQ_LIST
  const int seq_[] = SEQ_LIST;
  for (int li = 0; li < (int)(sizeof(seq_) / sizeof(int)); ++li) {
    int lo = seq_[li], hi = lo + 1;
#else
  (void)hipMemsetAsync((unsigned char*)d_ws + WS_STAT, 0, 16384, stream);
  for (int li = 0; li < N_SPLIT; ++li) {
    int lo = (34 * li) / N_SPLIT, hi = (34 * (li + 1)) / N_SPLIT;
#endif
    void* args[] = {&p, &lo, &hi};
    hipError_t e = hipLaunchCooperativeKernel((const void*)mega, dim3(grid_blocks), dim3(NTHR), args, LDS_BYTES, stream);
    if (e != hipSuccess) { fprintf(stderr, "cooperative launch failed: %s (grid %d)\n", hipGetErrorString(e), grid_blocks); break; }
  }
}
```
